# Optimizing an MI355X kernel written in HIP

```python
import math
import jax, jax.numpy as jnp
from jax import lax
import numpy as np

D_MODEL = 1024
BATCH = 8
SEQ = 4096
DEPTH = 2

CONV_CH = 512
CONV_KERNEL = 31
ATTN_HEADS = 8
ATTN_HEAD_DIM = 64
ATTN_W = ATTN_HEADS * ATTN_HEAD_DIM
SSD_HEADS = 8
SSD_HEAD_DIM = 64
SSD_W = SSD_HEADS * SSD_HEAD_DIM
SSD_GROUPS = 2
SSD_STATE = 64
SSD_CONV = 4
SSD_CONV_CH = SSD_W + 2 * SSD_GROUPS * SSD_STATE
SSD_CHUNK = 128
Q_BLOCK = 128
D_MIX = CONV_CH + ATTN_W + SSD_W
IN_SIZES = (2 * CONV_CH, ATTN_W, ATTN_W, ATTN_W, ATTN_HEADS,
            SSD_W, SSD_W, SSD_GROUPS * SSD_STATE, SSD_GROUPS * SSD_STATE, SSD_HEADS)
D_IN = sum(IN_SIZES)
MOE_GROUPS = 4
EXPERTS_PER_GROUP = 4
N_EXPERTS = MOE_GROUPS * EXPERTS_PER_GROUP
TOP_K_INNER = 2
D_EXPERT = 512
EPS = 1e-6

kernel_name = "hybrid_conv_fox_ssd_hmoe"


def rmsnorm(x, g):
    xf = x.astype(jnp.float32)
    y = xf * lax.rsqrt(jnp.mean(xf * xf, axis=-1, keepdims=True) + EPS)
    return (y * g.astype(jnp.float32)).astype(x.dtype)


def layernorm(x, g, b):
    xf = x.astype(jnp.float32)
    mu = jnp.mean(xf, axis=-1, keepdims=True)
    var = jnp.mean(jnp.square(xf - mu), axis=-1, keepdims=True)
    y = (xf - mu) * lax.rsqrt(var + EPS) * g.astype(jnp.float32) + b.astype(jnp.float32)
    return y.astype(x.dtype)


def causal_depthwise_conv(x, w, b):
    K, C = w.shape
    y = lax.conv_general_dilated(
        x, w[:, None, :].astype(x.dtype), window_strides=(1,), padding=[(K - 1, 0)],
        dimension_numbers=("NWC", "WIO", "NWC"), feature_group_count=C)
    return y + b.astype(x.dtype)


def split_cols(u, sizes):
    offs = np.cumsum(sizes)[:-1].tolist()
    return jnp.split(u, offs, axis=-1)


def conformer_conv(u, dw_w, dw_b, ln_g, ln_b):
    a, gate = jnp.split(u, 2, axis=-1)
    h = a * jax.nn.sigmoid(gate)
    h = causal_depthwise_conv(h, dw_w, dw_b)
    h = layernorm(h, ln_g, ln_b)
    return jax.nn.silu(h)


def forgetting_attention(q, k, v, f_logit):
    Bn, L, _ = q.shape
    scale = ATTN_HEAD_DIM ** -0.5
    q = q.reshape(Bn, L, ATTN_HEADS, ATTN_HEAD_DIM) * scale
    k = k.reshape(Bn, L, ATTN_HEADS, ATTN_HEAD_DIM)
    v = v.reshape(Bn, L, ATTN_HEADS, ATTN_HEAD_DIM)
    log_f = jax.nn.log_sigmoid(f_logit.astype(jnp.float32))
    cum = jnp.transpose(jnp.cumsum(log_f, axis=1), (0, 2, 1))
    outs = []
    for i in range(L // Q_BLOCK):
        q0 = i * Q_BLOCK
        end = q0 + Q_BLOCK
        s = jnp.einsum('bqhd,bkhd->bhqk', q[:, q0:end], k[:, :end]).astype(jnp.float32)
        s = s + cum[:, :, q0:end, None] - cum[:, :, None, :end]
        qpos = q0 + jnp.arange(Q_BLOCK)
        kpos = jnp.arange(end)
        s = jnp.where(kpos[None, :] <= qpos[:, None], s, -jnp.inf)
        p = jax.nn.softmax(s, axis=-1)
        outs.append(jnp.einsum('bhqk,bkhd->bqhd', p.astype(v.dtype), v[:, :end]))
    o = jnp.concatenate(outs, axis=1)
    return o.reshape(Bn, L, ATTN_W)


def ssd_chunked(x, a, Bm, Cm):
    Bn, L, H, P = x.shape
    G, N = Bm.shape[2], Bm.shape[3]
    R = H // G
    T = SSD_CHUNK
    nc = L // T
    x = x.reshape(Bn, nc, T, G, R, P)
    a = a.reshape(Bn, nc, T, G, R)
    Bm = Bm.reshape(Bn, nc, T, G, N)
    Cm = Cm.reshape(Bn, nc, T, G, N)
    a_cum = jnp.cumsum(a, axis=2)
    seg = a_cum[:, :, :, None] - a_cum[:, :, None, :]
    causal = jnp.tril(jnp.ones((T, T), dtype=bool))[None, None, :, :, None, None]
    Lmat = jnp.exp(jnp.where(causal, seg, -jnp.inf))
    CB = jnp.einsum('bctgn,bcsgn->bctsg', Cm, Bm)
    y_diag = jnp.einsum('bctsgr,bcsgrp->bctgrp', CB[..., None] * Lmat, x)
    decay_to_end = jnp.exp(a_cum[:, :, -1:] - a_cum)
    states = jnp.einsum('bctgn,bctgrp->bcgrpn', Bm, x * decay_to_end[..., None])
    chunk_decay = jnp.exp(a_cum[:, :, -1])

    def step(h, inp):
        s_c, d_c = inp
        return h * d_c[..., None, None] + s_c, h

    h0 = jnp.zeros((Bn, G, R, P, N), dtype=states.dtype)
    _, h_prev = lax.scan(step, h0, (jnp.moveaxis(states, 1, 0), jnp.moveaxis(chunk_decay, 1, 0)))
    h_prev = jnp.moveaxis(h_prev, 0, 1)
    y_off = jnp.einsum('bctgn,bcgrpn->bctgrp', Cm, h_prev) * jnp.exp(a_cum)[..., None]
    return (y_diag + y_off).reshape(Bn, L, H, P)


def ssd_mixer(z, xs, Bm, Cm, dt_raw, conv_w, conv_b, dt_bias, A_log, D_skip, norm_g):
    Bn, L, _ = xs.shape
    xbc = jax.nn.silu(causal_depthwise_conv(jnp.concatenate([xs, Bm, Cm], axis=-1), conv_w, conv_b))
    xs, Bm, Cm = split_cols(xbc, (SSD_W, SSD_GROUPS * SSD_STATE, SSD_GROUPS * SSD_STATE))
    x = xs.reshape(Bn, L, SSD_HEADS, SSD_HEAD_DIM).astype(jnp.float32)
    Bm = Bm.reshape(Bn, L, SSD_GROUPS, SSD_STATE).astype(jnp.float32)
    Cm = Cm.reshape(Bn, L, SSD_GROUPS, SSD_STATE).astype(jnp.float32)
    dt = jax.nn.softplus(dt_raw.astype(jnp.float32) + dt_bias.astype(jnp.float32))
    A = -jnp.exp(A_log.astype(jnp.float32))
    y = ssd_chunked(x * dt[..., None], dt * A, Bm, Cm)
    y = y + x * D_skip.astype(jnp.float32)[:, None]
    y = y.reshape(Bn, L, SSD_W).astype(z.dtype)
    return rmsnorm(y * jax.nn.silu(z), norm_g)


def hierarchical_moe(x, wg, bg, we, be, w_gate, w_up, w_down):
    Bn, L, _ = x.shape
    g_prob = jax.nn.softmax((x @ wg).astype(jnp.float32) + bg.astype(jnp.float32), axis=-1)
    g_val, g_idx = lax.top_k(g_prob, 1)
    e_logits = ((x @ we).astype(jnp.float32) + be.astype(jnp.float32)).reshape(
        Bn, L, MOE_GROUPS, EXPERTS_PER_GROUP)
    e_sel = jnp.take_along_axis(e_logits, g_idx[..., None], axis=2)[:, :, 0]
    e_val, e_idx = lax.top_k(e_sel, TOP_K_INNER)
    e_w = jax.nn.softmax(e_val, axis=-1) * g_val
    expert_id = g_idx * EXPERTS_PER_GROUP + e_idx
    combine = jnp.sum(jax.nn.one_hot(expert_id, N_EXPERTS, dtype=jnp.float32) * e_w[..., None], axis=-2)
    combine = combine.astype(x.dtype)
    out = jnp.zeros_like(x)
    for e in range(N_EXPERTS):
        h = jax.nn.silu(x @ w_gate[e]) * (x @ w_up[e])
        out = out + combine[..., e:e + 1] * (h @ w_down[e])
    return out


def setup_inputs(seed: int = 0) -> dict:
    key = jax.random.key(seed)
    ks = iter(jax.random.split(key, 32))
    nrm = lambda shape, s: jax.random.normal(next(ks), shape, jnp.float32) * s
    x = nrm((BATCH, SEQ, D_MODEL), 1.0)
    norm_mix = 1.0 + nrm((DEPTH, D_MODEL), 0.02)
    w_in = nrm((DEPTH, D_MODEL, D_IN), D_MODEL ** -0.5)
    conv_dw_w = nrm((DEPTH, CONV_KERNEL, CONV_CH), CONV_KERNEL ** -0.5)
    conv_dw_b = nrm((DEPTH, CONV_CH), 0.01)
    conv_ln_g = 1.0 + nrm((DEPTH, CONV_CH), 0.02)
    conv_ln_b = nrm((DEPTH, CONV_CH), 0.01)
    fgate_b = jax.random.uniform(next(ks), (DEPTH, ATTN_HEADS), jnp.float32, 1.0, 6.0)
    ssd_conv_w = nrm((DEPTH, SSD_CONV, SSD_CONV_CH), SSD_CONV ** -0.5)
    ssd_conv_b = nrm((DEPTH, SSD_CONV_CH), 0.01)
    u = jax.random.uniform(next(ks), (DEPTH, SSD_HEADS), jnp.float32)
    dt0 = jnp.exp(u * (math.log(0.1) - math.log(0.001)) + math.log(0.001))
    ssd_dt_bias = dt0 + jnp.log(-jnp.expm1(-dt0))
    ssd_A_log = jnp.log(jax.random.uniform(next(ks), (DEPTH, SSD_HEADS), jnp.float32, 1.0, 16.0))
    ssd_D = 1.0 + nrm((DEPTH, SSD_HEADS), 0.1)
    ssd_norm_g = 1.0 + nrm((DEPTH, SSD_W), 0.02)
    w_out = nrm((DEPTH, D_MIX, D_MODEL), D_MIX ** -0.5)
    norm_ffn = 1.0 + nrm((DEPTH, D_MODEL), 0.02)
    router_group_w = nrm((DEPTH, D_MODEL, MOE_GROUPS), D_MODEL ** -0.5)
    router_group_b = nrm((DEPTH, MOE_GROUPS), 0.01)
    router_expert_w = nrm((DEPTH, D_MODEL, N_EXPERTS), D_MODEL ** -0.5)
    router_expert_b = nrm((DEPTH, N_EXPERTS), 0.01)
    expert_w_gate = nrm((DEPTH, N_EXPERTS, D_MODEL, D_EXPERT), D_MODEL ** -0.5)
    expert_w_up = nrm((DEPTH, N_EXPERTS, D_MODEL, D_EXPERT), D_MODEL ** -0.5)
    expert_w_down = nrm((DEPTH, N_EXPERTS, D_EXPERT, D_MODEL), D_EXPERT ** -0.5)
    norm_final = 1.0 + nrm((D_MODEL,), 0.02)
    return {"x": x, "norm_mix": norm_mix, "w_in": w_in, "conv_dw_w": conv_dw_w, "conv_dw_b": conv_dw_b,
            "conv_ln_g": conv_ln_g, "conv_ln_b": conv_ln_b, "fgate_b": fgate_b, "ssd_conv_w": ssd_conv_w,
            "ssd_conv_b": ssd_conv_b, "ssd_dt_bias": ssd_dt_bias, "ssd_A_log": ssd_A_log, "ssd_D": ssd_D,
            "ssd_norm_g": ssd_norm_g, "w_out": w_out, "norm_ffn": norm_ffn, "router_group_w": router_group_w,
            "router_group_b": router_group_b, "router_expert_w": router_expert_w,
            "router_expert_b": router_expert_b, "expert_w_gate": expert_w_gate, "expert_w_up": expert_w_up,
            "expert_w_down": expert_w_down, "norm_final": norm_final}


def reference(x, norm_mix, w_in, conv_dw_w, conv_dw_b, conv_ln_g, conv_ln_b, fgate_b, ssd_conv_w,
              ssd_conv_b, ssd_dt_bias, ssd_A_log, ssd_D, ssd_norm_g, w_out, norm_ffn, router_group_w,
              router_group_b, router_expert_w, router_expert_b, expert_w_gate, expert_w_up,
              expert_w_down, norm_final):
    for l in range(DEPTH):
        h = rmsnorm(x, norm_mix[l])
        u = h @ w_in[l]
        (u_conv, q, k, v, f_logit, z, xs, Bm, Cm, dt_raw) = split_cols(u, IN_SIZES)
        y_conv = conformer_conv(u_conv, conv_dw_w[l], conv_dw_b[l], conv_ln_g[l], conv_ln_b[l])
        y_attn = forgetting_attention(q, k, v, f_logit + fgate_b[l].astype(f_logit.dtype))
        y_ssd = ssd_mixer(z, xs, Bm, Cm, dt_raw, ssd_conv_w[l], ssd_conv_b[l], ssd_dt_bias[l],
                          ssd_A_log[l], ssd_D[l], ssd_norm_g[l])
        y = jnp.concatenate([y_conv, y_attn.astype(x.dtype), y_ssd], axis=-1) @ w_out[l]
        x = x + y.astype(x.dtype)
        hf = rmsnorm(x, norm_ffn[l])
        x = x + hierarchical_moe(hf, router_group_w[l], router_group_b[l], router_expert_w[l],
                                 router_expert_b[l], expert_w_gate[l], expert_w_up[l],
                                 expert_w_down[l]).astype(x.dtype)
    return rmsnorm(x, norm_final)
```

```cpp
#include <hip/hip_runtime.h>
#include <hip/hip_bf16.h>
#include <cstdio>
#include <cstdint>
#include <cmath>

#ifndef DUP_MASK
#define DUP_MASK 0
#endif
#define DUPN(j) (1 + ((DUP_MASK >> (j)) & 1))
#ifndef MK_PER_PHASE
#define MK_PER_PHASE 0
#endif

constexpr int NB = 8, SEQ = 4096, DM = 1024, M = NB * SEQ, DEPTH = 2;
constexpr int D_IN = 3856, D_MIX = 1536;
constexpr int NEXP = 16, DEXP = 512;
constexpr float EPS = 1e-6f;
constexpr float LOG2E = 1.4426950408889634f;
constexpr float C2 = 0.125f * LOG2E;
constexpr int UP = 3328, UC_GLU = 0, UC_Q = 512, UC_K = 1024, UC_V = 1536, UC_Z = 2048, UC_XS = 2560, UC_B = 3072, UC_C = 3200;
constexpr int YP = 1536, YC_CONV = 0, YC_ATT = 512, YC_SSD = 1024;
constexpr int NV_IN = 4096;
#ifndef NT8_IN
#define NT8_IN 10
#endif
constexpr int NT8 = NT8_IN;
constexpr float IN_X_SCALE = 8.f, IN_W_SCALE = 64.f, IN_DESCALE = 1.f / (IN_X_SCALE * IN_W_SCALE);
constexpr float OUT_Y_SCALE = 8.f, OUT_W_SCALE = 64.f; constexpr unsigned OUT_SCA = 0x7c7c7c7cu, OUT_SCB = 0x79797979u;
constexpr int NBUCKET = 24, BCAP = 32768;

constexpr size_t MiB = 1u << 20;
constexpr size_t WS_CTL = 0, CTL_ZERO_BYTES = 128 * 1024;
constexpr size_t WS_WIN = 1 * MiB;
constexpr size_t WS_WOUT = 17 * MiB;
constexpr size_t WS_WGU = 23 * MiB;
constexpr size_t WS_WD = 87 * MiB;
constexpr size_t WS_FD = 119 * MiB;
constexpr size_t WS_FC = 121 * MiB;
constexpr size_t WS_PERM = 122 * MiB;
constexpr size_t WS_ROWW = 125 * MiB;
constexpr size_t WS_SST = 131 * MiB;
constexpr size_t WS_XN = 165 * MiB;
constexpr size_t WS_U = 261 * MiB;
constexpr size_t WS_XN8 = 55 * MiB;
constexpr size_t WS_WIN8 = 103 * MiB;
constexpr size_t WS_WOUT8 = 114 * MiB;
constexpr size_t WS_RSTD = 111 * MiB;
constexpr size_t WS_END = 485 * MiB;
constexpr int CW_TMO = 0, CW_CODE = 1;
constexpr int CW_BAR = 4096;
constexpr int CW_ATQ = 20480;
constexpr int CW_SCN = 16384;
constexpr int CW_HRDY = 24576;
constexpr int CW_CUR = 8192;

constexpr int RING_OFF = 0, RING_BYTES = 131072;
constexpr int LDSCTL_OFF = RING_BYTES, MISC_OFF = LDSCTL_OFF + 320;
constexpr int TBL_OFF = LDSCTL_OFF + 1024;
constexpr int TOK_OFF = LDSCTL_OFF + 4096, TOK_UNITS = 12;
constexpr int LDS_BYTES = 147456;

#define GAS __attribute__((address_space(1)))
#define LAS __attribute__((address_space(3)))
typedef unsigned short bf16;
typedef unsigned v4u __attribute__((ext_vector_type(4)));
typedef unsigned v2u __attribute__((ext_vector_type(2)));
typedef float f32x4 __attribute__((ext_vector_type(4)));
typedef float f32x2 __attribute__((ext_vector_type(2)));
typedef short bf16x8 __attribute__((ext_vector_type(8)));
typedef GAS unsigned gu32;
#define RLX_AGENT __ATOMIC_RELAXED, __HIP_MEMORY_SCOPE_AGENT
#define LDS_WAIT() asm volatile("s_waitcnt lgkmcnt(0)" ::: "memory")
#define VM_WAIT() asm volatile("s_waitcnt vmcnt(0)" ::: "memory")
typedef __bf16 bf16x2_hw __attribute__((ext_vector_type(2)));
__device__ __forceinline__ unsigned pk2(float lo, float hi) { const f32x2 v = {lo, hi}; return __builtin_bit_cast(unsigned, __builtin_convertvector(v, bf16x2_hw)); }
__device__ __forceinline__ unsigned f2bf(float f) { return pk2(f, 0.f) & 0xffffu; }
__device__ __forceinline__ float bf2f(unsigned h) { return __builtin_bit_cast(float, h << 16); }
__device__ __forceinline__ float bflo(unsigned w) { return __builtin_bit_cast(float, w << 16); }
__device__ __forceinline__ float bfhi(unsigned w) { return __builtin_bit_cast(float, w & 0xffff0000u); }
__device__ __forceinline__ float sigmoidf_(float x) { return __builtin_amdgcn_rcpf(1.0f + __expf(-x)); }
__device__ __forceinline__ float siluf_(float x) { return x * sigmoidf_(x); }
#define swz_xor(v, pat) __builtin_bit_cast(float, __builtin_amdgcn_ds_swizzle(__builtin_bit_cast(int, (float)(v)), (pat)))
#define DPP_F(v, ctrl) __builtin_bit_cast(float, __builtin_amdgcn_mov_dpp(__builtin_bit_cast(int, (float)(v)), (ctrl), 0xf, 0xf, true))
__device__ __forceinline__ float wave_sum(float v) {
    v += DPP_F(v, 0xB1);
    v += DPP_F(v, 0x4E);
    v += DPP_F(v, 0x141);
    v += DPP_F(v, 0x140);
    const int vb = __builtin_bit_cast(int, v);
    return (__builtin_bit_cast(float, __builtin_amdgcn_readlane(vb, 0)) + __builtin_bit_cast(float, __builtin_amdgcn_readlane(vb, 16))) + (__builtin_bit_cast(float, __builtin_amdgcn_readlane(vb, 32)) + __builtin_bit_cast(float, __builtin_amdgcn_readlane(vb, 48)));
}
#define XB_TMO      128
#define XB_XCNT(j)  (256  + 64 * (j))
#define XB_XSUB(j)  (1280 + 64 * (j))
#define XB_XGEN(j)  (2304 + 64 * (j))
#define XB_TOP      3328
#define XB_TOPGEN   3392
#define XCD_BAR_WORDS 3456
#define XB_SPIN_CAP (1u << 18)
__device__ __forceinline__ unsigned xb_ld(unsigned* p)              { return __hip_atomic_load(p, __ATOMIC_RELAXED, __HIP_MEMORY_SCOPE_AGENT); }
__device__ __forceinline__ unsigned xb_add(unsigned* p, unsigned v) { return __hip_atomic_fetch_add(p, v, __ATOMIC_RELAXED, __HIP_MEMORY_SCOPE_AGENT); }
__device__ __forceinline__ unsigned xb_xcc_id() { return (unsigned)__builtin_amdgcn_s_getreg((3 << 11) | 20) & 0xFu; }
#define XB_SPIN(cond, bar) do { unsigned _sp = 0; while (cond) { __builtin_amdgcn_s_sleep(1); \
    if ((++_sp & 255u) == 0u) { if (xb_ld(&(bar)[XB_TMO])) break; if (_sp > XB_SPIN_CAP) { atomicAdd(&(bar)[XB_TMO], 1u); break; } } } } while (0)
struct XcdBarrier { unsigned* bar; unsigned x; volatile LAS unsigned* st; };
__device__ __forceinline__ XcdBarrier xcd_barrier_post(unsigned* bar, volatile LAS unsigned* st) {
    XcdBarrier b; b.bar = bar; b.x = xb_xcc_id(); b.st = st;
    if (threadIdx.x == 0) (void)xb_add(&bar[XB_XCNT(b.x)], 1u);
    return b;
}
__device__ __forceinline__ void xcd_barrier_complete(unsigned* bar, unsigned x, unsigned& nloc, unsigned& nx) {
    const unsigned G = gridDim.x * gridDim.y * gridDim.z;
    unsigned sum, cnt, mine, sp = 0u;
    for (;;) {
        sum = 0u; cnt = 0u; mine = 0u;
#pragma unroll
        for (unsigned j = 0; j < 16; ++j) { const unsigned c = xb_ld(&bar[XB_XCNT(j)]); sum += c; cnt += (c > 0u) ? 1u : 0u; mine = (j == x) ? c : mine; }
        if (sum == G) break;
        __builtin_amdgcn_s_sleep(1);
        if ((++sp & 255u) == 0u) { if (xb_ld(&bar[XB_TMO])) break; if (sp > XB_SPIN_CAP) { atomicAdd(&bar[XB_TMO], 1u); break; } }
    }
    nloc = mine > 0u ? mine : 1u; nx = cnt > 0u ? cnt : 1u;
}
__device__ __forceinline__ void xcd_barrier(const XcdBarrier& b) {
    asm volatile("s_waitcnt vmcnt(0)" ::: "memory");
    __syncthreads();
    if (threadIdx.x == 0) {
        unsigned* bar = b.bar; asm volatile("" : "+s"(bar));
        __builtin_amdgcn_s_waitcnt(0);
        unsigned nloc = b.st[0], nx = b.st[1];
        unsigned bx_ = b.x; asm volatile("" : "+s"(bx_));
        if (nloc == 0u) { xcd_barrier_complete(bar, bx_, nloc, nx); b.st[0] = nloc; b.st[1] = nx; }
        const unsigned old = xb_add(&bar[XB_XSUB(bx_)], 1u);
        const unsigned gen = old / nloc;
        if (old + 1u == (gen + 1u) * nloc) {
            __builtin_amdgcn_fence(__ATOMIC_RELEASE, "agent");
            asm volatile("s_waitcnt vmcnt(0)" ::: "memory");
            const unsigned og = xb_add(&bar[XB_TOP], 1u);
            const unsigned tg = og / nx;
            if (og + 1u == (tg + 1u) * nx) xb_add(&bar[XB_TOPGEN], 1u);
            else XB_SPIN(xb_ld(&bar[XB_TOPGEN]) == tg, bar);
            __builtin_amdgcn_fence(__ATOMIC_ACQUIRE, "agent");
            xb_add(&bar[XB_XGEN(bx_)], 1u);
            asm volatile("s_waitcnt vmcnt(0)" ::: "memory");
        } else {
            XB_SPIN(xb_ld(&bar[XB_XGEN(bx_)]) == gen, bar);
            __builtin_amdgcn_fence(__ATOMIC_ACQUIRE, "agent");
            asm volatile("s_waitcnt vmcnt(0)" ::: "memory");
        }
    }
    __syncthreads();
}

struct Args { const float* in[24]; float* out; unsigned char* ws; int ph_lo, ph_hi, li, pad; };
struct Frame {
    LAS unsigned char* lds;
    volatile LAS unsigned* MISC;
    gu32* ctl;
    int tid, lane, wave, vcu, G, wave0, vcu0, G0;
};

__device__ __forceinline__ int opaque_s(int v) { asm volatile("" : "+s"(v)); return v; }
__device__ __forceinline__ bool relaunder(Frame& F) { int w = F.wave0; asm volatile("" : "+s"(w)); int ln; asm volatile("v_mbcnt_lo_u32_b32 %0, -1, 0\n\tv_mbcnt_hi_u32_b32 %0, -1, %0" : "=v"(ln)); int t = w * 64 + ln; asm volatile("" : "+v"(t)); F.tid = t; F.lane = t & 63; F.wave = w; F.vcu = opaque_s(F.vcu0); F.G = opaque_s(F.G0); return true; }
constexpr int PTAB_OFF = LDSCTL_OFF + 512;
__device__ __forceinline__ const float* inptr(const Frame& F, int k) {
    const volatile LAS unsigned* p = (const volatile LAS unsigned*)(F.lds + PTAB_OFF) + 2 * k;
    const unsigned lo = __builtin_amdgcn_readfirstlane(p[0]), hi = __builtin_amdgcn_readfirstlane(p[1]);
    return (const float*)(const GAS float*)(((unsigned long long)hi << 32) | lo);
}
constexpr float MOE_X_SCALE = 8.f, MOE_WGU_SCALE = 64.f, MOE_H_SCALE = 8.f, MOE_WD_SCALE = 32.f;
constexpr float MOE_GU_DESCALE = 1.f / (MOE_X_SCALE * MOE_WGU_SCALE), MOE_DN_DESCALE = 1.f / (MOE_H_SCALE * MOE_WD_SCALE);
__host__ __device__ __forceinline__ int perm32(int rho) { const int n = rho >> 4, i = rho & 15; return 8 * (i >> 2) + 4 * n + (i & 3); }
struct Unit { int pm, pn, q, tb, cnt, ord, kind; };

#ifndef WGM_
#define WGM_ 8
#endif
struct DenseSched {
    static constexpr bool GATHER = false, FUSED = false, MIX = false;
    const char* Bt; int nM, nN, lda, ldb, G, c, pn0;
    __device__ __forceinline__ bool next(int i, Unit& u) const {
        const long L = (long)i * G + c; const int nwg = nM * nN; if (L >= nwg) return false;
        int wgid = (int)L; { const int q = nwg / 8, r = nwg % 8, xcd = wgid % 8, off = wgid / 8; wgid = (xcd < r ? xcd * (q + 1) : r * (q + 1) + (xcd - r) * q) + off; }
        const int nig = WGM_ * nN, gid = wgid / nig, fm = gid * WGM_, gsz = (nM - fm) < WGM_ ? (nM - fm) : WGM_;
        u.pm = fm + ((wgid % nig) % gsz); u.pn = pn0 + (wgid % nig) / gsz; u.q = 0; u.tb = 0; u.cnt = 0; u.ord = i; u.kind = 0; return true;
    }
    __device__ __forceinline__ unsigned a_rowoff(const Unit& u, int rloc) const { return (unsigned)(u.pm * 256 + rloc) * (unsigned)lda; }
    __device__ __forceinline__ size_t a_tile(const Unit& u) const { return (size_t)u.pm * 256 * lda; }
    __device__ __forceinline__ const char* b_tile(const Unit& u, int kt) const { return Bt + (size_t)(u.pn - pn0) * 256 * ldb + (size_t)kt * 128; }
};
struct OutSched {
    static constexpr bool GATHER = false, FUSED = false, MIX = true;
    const char* Bt; const char* Bt8; const char* A8; int nM, nN, lda, ldb, G, c;
    __device__ __forceinline__ bool next(int i, Unit& u) const {
        const long L = (long)i * G + c; const int nwg = nM * nN; if (L >= nwg) return false;
        int wgid = (int)L; { const int q = nwg / 8, r = nwg % 8, xcd = wgid % 8, off = wgid / 8; wgid = (xcd < r ? xcd * (q + 1) : r * (q + 1) + (xcd - r) * q) + off; }
        const int nig = WGM_ * nN, gid = wgid / nig, fm = gid * WGM_, gsz = (nM - fm) < WGM_ ? (nM - fm) : WGM_;
        u.pm = fm + ((wgid % nig) % gsz); u.pn = (wgid % nig) / gsz; u.q = 0; u.tb = 0; u.cnt = 0; u.ord = i; u.kind = 0; return true;
    }
    __device__ __forceinline__ unsigned a_rowoff(const Unit& u, int rloc) const { return (unsigned)(u.pm * 256 + rloc) * (unsigned)lda; }
    __device__ __forceinline__ size_t a_tile(const Unit& u) const { return (size_t)u.pm * 256 * lda; }
    static constexpr int K8_0 = 16;
    __device__ __forceinline__ bool is8(int kt) const { return kt >= K8_0; }
    __device__ __forceinline__ size_t a_koff(int kt) const { return kt < 8 ? (size_t)kt * 128 : (size_t)(kt - 8) * 128 + 2048; }
    __device__ __forceinline__ const char* b_tile(const Unit& u, int kt) const {
        if (is8(kt)) return Bt8 + (size_t)u.pn * 256 * 512 + (size_t)(kt - K8_0) * 128;
        return Bt + (size_t)u.pn * 256 * ldb + a_koff(kt);
    }
};
__device__ __forceinline__ void bucket_experts(int q, int& elo, int& ehi) { const int g = q / 6, p = q % 6; const int lo = p < 3 ? 0 : (p < 5 ? 1 : 2), hi = p < 3 ? p + 1 : (p < 5 ? p - 1 : 3); elo = 4 * g + lo; ehi = 4 * g + hi; }
template <bool down> struct MoeSched {
    static constexpr bool GATHER = !down, FUSED = false, MIX = false;
    __device__ __forceinline__ size_t a_tile(const Unit& u) const { return (size_t)u.pm * 256 * 1024; }
    const LAS int* tbl; const int* perm; const char* W; int NTN, G, c;
    __device__ __forceinline__ bool next(int i, Unit& u) const {
        const int L = i * G + c; const int ttot = __builtin_amdgcn_readfirstlane(tbl[32 + 192 + 192]); if (L >= ttot * NTN) return false;
        const int mt = L / NTN; u.pm = mt; u.pn = L % NTN; u.q = __builtin_amdgcn_readfirstlane(tbl[32 + mt]); u.tb = __builtin_amdgcn_readfirstlane(tbl[32 + 192 + mt]); u.cnt = __builtin_amdgcn_readfirstlane(tbl[u.q]); u.ord = i; u.kind = down ? 1 : 0; return true;
    }
    __device__ __forceinline__ unsigned a_rowoff(const Unit& u, int rloc) const {
        if (down) return (unsigned)(u.pm * 256 + rloc) * 1024u;
        if (u.ord < TOK_UNITS) return (unsigned)tbl[(TOK_OFF - TBL_OFF) / 4 + u.ord * 256 + rloc] * 1024u;
        int r = u.tb * 256 + rloc; r = r < u.cnt ? r : u.cnt - 1;
        return (unsigned)perm[u.q * BCAP + r] * 1024u;
    }
    __device__ __forceinline__ const char* b_tile(const Unit& u, int kt) const {
        int elo, ehi; bucket_experts(u.q, elo, ehi);
        if (!down) { const int e = (u.pn >> 2) ? ehi : elo; return W + (size_t)e * 1024 * 1024 + (size_t)(u.pn & 3) * 256 * 1024 + (size_t)kt * 128; }
        const int e = kt < 4 ? elo : ehi; return W + (size_t)e * 1024 * 512 + (size_t)u.pn * 256 * 512 + (size_t)(kt & 3) * 128;
    }
};

struct MoeSchedF {
    static constexpr bool GATHER = true, FUSED = true, MIX = false;
    const LAS int* tbl; const int* perm; const char* Wgu; const char* Wd; unsigned offX, offH; gu32* rdy; gu32* tmo; int G, c;
    __device__ __forceinline__ size_t a_tile(const Unit&) const { return 0; }
    __device__ __forceinline__ bool next(int i, Unit& u) const {
        const int L = i * G + c; const int ttot = __builtin_amdgcn_readfirstlane(tbl[32 + 192 + 192]); if (L >= ttot * 12) return false;
        int mt; if (L < ttot * 8) { u.kind = 0; mt = L >> 3; u.pn = L & 7; } else { const int L2 = L - ttot * 8; u.kind = 1; mt = L2 >> 2; u.pn = L2 & 3; }
        u.pm = mt; u.q = __builtin_amdgcn_readfirstlane(tbl[32 + mt]); u.tb = __builtin_amdgcn_readfirstlane(tbl[32 + 192 + mt]); u.cnt = __builtin_amdgcn_readfirstlane(tbl[u.q]); u.ord = i; return true;
    }
    __device__ __forceinline__ unsigned a_rowoff(const Unit& u, int rloc) const {
        if (u.kind) return offH + (unsigned)(u.pm * 256 + rloc) * 1024u;
        if (u.ord < TOK_UNITS) return offX + (unsigned)tbl[(TOK_OFF - TBL_OFF) / 4 + u.ord * 256 + rloc] * 1024u;
        int r = u.tb * 256 + rloc; r = r < u.cnt ? r : u.cnt - 1;
        return offX + (unsigned)perm[u.q * BCAP + r] * 1024u;
    }
    __device__ __forceinline__ const char* b_tile(const Unit& u, int kt) const {
        int elo, ehi; bucket_experts(u.q, elo, ehi);
        if (!u.kind) { const int e = (u.pn >> 2) ? ehi : elo; return Wgu + (size_t)e * 1024 * 1024 + (size_t)(u.pn & 3) * 256 * 1024 + (size_t)kt * 128; }
        const int e = kt < 4 ? elo : ehi; return Wd + (size_t)e * 1024 * 512 + (size_t)u.pn * 256 * 512 + (size_t)(kt & 3) * 128;
    }
    __device__ __forceinline__ int ldb_of(const Unit& u) const { return u.kind ? 512 : 1024; }
    __device__ __forceinline__ bool perm_of(const Unit& u) const { return !u.kind; }
    __device__ __forceinline__ void publish(int pm, int) const { const int ln = __builtin_amdgcn_mbcnt_hi(-1, __builtin_amdgcn_mbcnt_lo(-1, 0)); if (ln == 0) __hip_atomic_fetch_add(rdy + __builtin_amdgcn_readfirstlane(pm) * 16, 1u, RLX_AGENT); }
    __device__ __forceinline__ void a_wait(const Unit& u) const {
        if (!u.kind) return;
        gu32* p = rdy + u.pm * 16; unsigned sp = 0;
        while (__hip_atomic_load(p, RLX_AGENT) < 64u) { __builtin_amdgcn_s_sleep(2); if (++sp > (1u << 21)) { __hip_atomic_store(tmo, 0xF05Eu, RLX_AGENT); break; } }
    }
};

namespace pg8 {
constexpr int HALF = 128, HTB = HALF * 64 * 2;
__device__ __forceinline__ int lds_byte(int r, int c) { const int st = (r >> 4) * 2 + (c >> 5), rr = r & 15, cc = c & 31, ob = rr * 64 + cc * 2; return st * 1024 + (ob ^ (((ob >> 9) & 1) << 5)); }
__device__ __forceinline__ void stage_rc(int b, int& R, int& C) { const int st = b / 1024, sb = b % 1024, swz = sb ^ (((sb >> 9) & 1) << 5); R = (st >> 1) * 16 + swz / 64; C = (st & 1) * 32 + (swz % 64) / 2; }
template <class Epi, class Sched, bool ALIGN_EPI, bool FP8>
__device__ __forceinline__ void gemm_phase(LAS unsigned char* lds, int tid, const char* Abase, int nt, int lda, int ldb, const Sched& S, const Epi& E) {
    const int wid = __builtin_amdgcn_readfirstlane(tid >> 6), lane = tid & 63, wr = wid >> 2, wc = wid & 3, fr = lane & 15, fq = lane >> 4;
    unsigned voffB[2], voffA[2];
#pragma unroll
    for (int i = 0; i < 2; ++i) { int sR, sC; stage_rc(tid * 16 + i * 8192, sR, sC); const int Rb = Epi::PERM ? ((sR & ~31) + perm32(sR & 31)) : sR; voffB[i] = (unsigned)(Rb * ldb + sC * 2); voffA[i] = (unsigned)(sR * lda + sC * 2); }
    size_t hstepB = (size_t)HALF * ldb; const size_t hstepA = (size_t)HALF * lda;
    constexpr bool TUP = FP8 || Sched::MIX;
    unsigned voff8[2] = {0u, 0u};
    if constexpr (Sched::MIX) {
#pragma unroll
        for (int i = 0; i < 2; ++i) { int sR, sC; stage_rc(tid * 16 + i * 8192, sR, sC); voff8[i] = (unsigned)(sR * 512 + sC * 2); } }
    const unsigned xA0 = voffA[0] ^ voff8[0], xA1 = voffA[1] ^ voff8[1], xB0 = voffB[0] ^ voff8[0], xB1 = voffB[1] ^ voff8[1];
#define PG8_SETB(un) do { const int ldb_ = S.ldb_of(un); const bool pf_ = S.perm_of(un); _Pragma("unroll") for (int _i = 0; _i < 2; ++_i) { int sR, sC; stage_rc(tid * 16 + _i * 8192, sR, sC); \
        const int Rb = pf_ ? ((sR & ~31) + perm32(sR & 31)) : sR; voffB[_i] = (unsigned)(Rb * ldb_ + sC * 2); } hstepB = (size_t)HALF * ldb_; } while (0)
    const unsigned ldsw = (unsigned)wid * 1024u;
    const int aoff = lds_byte(wr * 64 + fr, fq * 8), boff = lds_byte(wc * 32 + fr, fq * 8);
#define PG8_SA(b, h) (((b) * 2 + (h)) * pg8::HTB)
#define PG8_SB(b, h) ((4 + (b) * 2 + (h)) * pg8::HTB)
#define PG8_STAGE_A(bufoff, sel, kt, h) do { if constexpr (Sched::GATHER) { const char* g_ = Abase + (size_t)(kt) * 128; _Pragma("unroll") for (int _i = 0; _i < 2; ++_i) { const unsigned vo_ = vc[h][_i]; \
        __builtin_amdgcn_global_load_lds((const unsigned*)(g_ + vo_), (LAS unsigned*)(lds + (bufoff) + ldsw + _i * 8192), 16, 0, 0); } } else if constexpr (Sched::MIX) { \
        const bool k8_ = S.is8(kt); const char* g_ = k8_ ? S.A8 + (size_t)((sel) ? nxt.pm : cur.pm) * 131072 + (h) * 65536 + (size_t)((kt) - Sched::K8_0) * 128 : Abase + ((sel) ? nA : cA) + (h) * hstepA + S.a_koff(kt); \
        const unsigned mk_ = k8_ ? 0xffffffffu : 0u; unsigned v0_ = voffA[0] ^ (xA0 & mk_), v1_ = voffA[1] ^ (xA1 & mk_); asm volatile("" : "+v"(v0_), "+v"(v1_));     \
        __builtin_amdgcn_global_load_lds((const unsigned*)(g_ + v0_), (LAS unsigned*)(lds + (bufoff) + ldsw), 16, 0, 0); \
        __builtin_amdgcn_global_load_lds((const unsigned*)(g_ + v1_), (LAS unsigned*)(lds + (bufoff) + ldsw + 8192), 16, 0, 0); } else { \
        const char* g_ = Abase + ((sel) ? nA : cA) + (h) * hstepA + (size_t)(kt) * 128; _Pragma("unroll") for (int _i = 0; _i < 2; ++_i) \
        __builtin_amdgcn_global_load_lds((const unsigned*)(g_ + voffA[_i]), (LAS unsigned*)(lds + (bufoff) + ldsw + _i * 8192), 16, 0, 0); } } while (0)
#define PG8_STAGE_B(bufoff, bptr, h, k8) do { if constexpr (Sched::MIX) { const bool k8_ = (k8); const char* g_ = (bptr) + (h) * (k8_ ? (size_t)65536 : hstepB); const unsigned mk_ = k8_ ? 0xffffffffu : 0u; unsigned v0_ = voffB[0] ^ (xB0 & mk_), v1_ = voffB[1] ^ (xB1 & mk_); asm volatile("" : "+v"(v0_), "+v"(v1_)); \
        __builtin_amdgcn_global_load_lds((const unsigned*)(g_ + v0_), (LAS unsigned*)(lds + (bufoff) + ldsw), 16, 0, 0); \
        __builtin_amdgcn_global_load_lds((const unsigned*)(g_ + v1_), (LAS unsigned*)(lds + (bufoff) + ldsw + 8192), 16, 0, 0); } else { \
        const char* g_ = (bptr) + (h) * hstepB; _Pragma("unroll") for (int _i = 0; _i < 2; ++_i) \
        __builtin_amdgcn_global_load_lds((const unsigned*)(g_ + voffB[_i]), (LAS unsigned*)(lds + (bufoff) + ldsw + _i * 8192), 16, 0, 0); } } while (0)
#define PG8_LDA(dst, b, h) do { if constexpr (TUP) { _Pragma("unroll") for (int m = 0; m < 4; ++m) { const v4u lo_ = *(const LAS v4u*)(lds + PG8_SA(b, h) + aoff + m * 2048), hi_ = *(const LAS v4u*)(lds + PG8_SA(b, h) + aoff + m * 2048 + 1024); dst##8[m] = __builtin_shufflevector(lo_, hi_, 0, 1, 2, 3, 4, 5, 6, 7); } } else { \
        _Pragma("unroll") for (int m = 0; m < 4; ++m) _Pragma("unroll") for (int k = 0; k < 2; ++k) dst[m][k] = *(const LAS bf16x8*)(lds + PG8_SA(b, h) + aoff + m * 2048 + k * 1024); } } while (0)
#define PG8_LDB(dst, b, h) do { if constexpr (TUP) { _Pragma("unroll") for (int n = 0; n < 2; ++n) { const v4u lo_ = *(const LAS v4u*)(lds + PG8_SB(b, h) + boff + n * 2048), hi_ = *(const LAS v4u*)(lds + PG8_SB(b, h) + boff + n * 2048 + 1024); dst##8[n] = __builtin_shufflevector(lo_, hi_, 0, 1, 2, 3, 4, 5, 6, 7); } } else { \
        _Pragma("unroll") for (int n = 0; n < 2; ++n) _Pragma("unroll") for (int k = 0; k < 2; ++k) dst[n][k] = *(const LAS bf16x8*)(lds + PG8_SB(b, h) + boff + n * 2048 + k * 1024); } } while (0)
#define PG8_SUB0(x) __builtin_bit_cast(bf16x8, __builtin_shufflevector(x, x, 0, 1, 2, 3))
#define PG8_SUB1(x) __builtin_bit_cast(bf16x8, __builtin_shufflevector(x, x, 4, 5, 6, 7))
#define PG8_MMA(ai, bj, At, Bt) do { __builtin_amdgcn_s_setprio(1); if constexpr (FP8) { _Pragma("unroll") for (int m = 0; m < 4; ++m) _Pragma("unroll") for (int n = 0; n < 2; ++n) \
        asm volatile("v_mfma_scale_f32_16x16x128_f8f6f4 %0, %1, %2, %0, %3, %3 op_sel_hi:[0,0,0]" : "+v"(acc[ai][bj][m][n]) : "v"(Bt##8[n]), "v"(At##8[m]), "v"(sc8)); } else { \
        _Pragma("unroll") for (int m = 0; m < 4; ++m) _Pragma("unroll") for (int n = 0; n < 2; ++n) _Pragma("unroll") for (int k = 0; k < 2; ++k) \
        acc[ai][bj][m][n] = __builtin_amdgcn_mfma_f32_16x16x32_bf16(Bt[n][k], At[m][k], acc[ai][bj][m][n], 0, 0, 0); } __builtin_amdgcn_s_setprio(0); } while (0)
#define PG8_PIN(At, Bt) do { _Pragma("unroll") for (int m = 0; m < 4; ++m) asm volatile("" : "+v"(At##8[m])); _Pragma("unroll") for (int n = 0; n < 2; ++n) asm volatile("" : "+v"(Bt##8[n])); } while (0)
#define PG8_MMA8S(ai, bj, At, Bt) do { __builtin_amdgcn_s_setprio(1); _Pragma("unroll") for (int m = 0; m < 4; ++m) _Pragma("unroll") for (int n = 0; n < 2; ++n) \
        asm volatile("v_mfma_scale_f32_16x16x128_f8f6f4 %0, %1, %2, %0, %3, %4 op_sel_hi:[0,0,0]" : "+v"(acc[ai][bj][m][n]) : "v"(Bt##8[n]), "v"(At##8[m]), "v"(scB8), "v"(scA8)); __builtin_amdgcn_s_setprio(0); } while (0)
#define PG8_MMAB(ai, bj, At, Bt) do { __builtin_amdgcn_s_setprio(1); _Pragma("unroll") for (int m = 0; m < 4; ++m) _Pragma("unroll") for (int n = 0; n < 2; ++n) { \
        acc[ai][bj][m][n] = __builtin_amdgcn_mfma_f32_16x16x32_bf16(PG8_SUB0(Bt##8[n]), PG8_SUB0(At##8[m]), acc[ai][bj][m][n], 0, 0, 0); \
        acc[ai][bj][m][n] = __builtin_amdgcn_mfma_f32_16x16x32_bf16(PG8_SUB1(Bt##8[n]), PG8_SUB1(At##8[m]), acc[ai][bj][m][n], 0, 0, 0); } __builtin_amdgcn_s_setprio(0); } while (0)
#define PG8_WAIT_V(n) asm volatile("s_waitcnt vmcnt(" #n ")" ::: "memory")
#define PG8_WAIT_L(n) asm volatile("s_waitcnt lgkmcnt(" #n ")" ::: "memory")
#define PG8_BAR __builtin_amdgcn_s_barrier()
#define PG8_SCHED __builtin_amdgcn_sched_barrier(0)
#define PG8_VOFFS(dst, un) do { if constexpr (Sched::GATHER) { _Pragma("unroll") for (int _i = 0; _i < 2; ++_i) { int sR, sC; stage_rc(tid * 16 + _i * 8192, sR, sC); _Pragma("unroll") for (int _h = 0; _h < 2; ++_h) dst[_h][_i] = S.a_rowoff(un, _h * 128 + sR) + (unsigned)sC * 2u; } } } while (0)
#define PG8_BODY(MM) PG8_LDB(B0, 0, 0); PG8_LDB(B1, 0, 1); PG8_SCHED; PG8_LDA(At, 0, 0); PG8_STAGE_A(PG8_SA(1, 1), false, t + 1, 1); \
            PG8_WAIT_V(8); PG8_WAIT_L(0); PG8_BAR; MM(0, 0, At, B0); MM(0, 1, At, B1); PG8_BAR; PG8_SCHED; \
            if constexpr (Sched::GATHER) { if (last && has_next) { PG8_VOFFS(vc, nxt); } } \
            PG8_LDA(At, 0, 1); PG8_STAGE_B(PG8_SB(0, 0), b2, 0, k82); PG8_STAGE_B(PG8_SB(0, 1), b2, 1, k82); PG8_STAGE_A(PG8_SA(0, 0), last, kt2, 0); \
            PG8_WAIT_V(8); PG8_WAIT_L(0); PG8_BAR; MM(1, 0, At, B0); MM(1, 1, At, B1); PG8_BAR; PG8_SCHED; \
            PG8_LDB(B0, 1, 0); PG8_LDB(B1, 1, 1); PG8_SCHED; PG8_LDA(At, 1, 0); PG8_STAGE_A(PG8_SA(0, 1), last, kt2, 1); \
            PG8_WAIT_V(8); PG8_WAIT_L(0); PG8_BAR; MM(0, 0, At, B0); MM(0, 1, At, B1); PG8_BAR; PG8_SCHED; \
            PG8_LDA(At, 1, 1); PG8_STAGE_B(PG8_SB(1, 0), b3, 0, k82); PG8_STAGE_B(PG8_SB(1, 1), b3, 1, k82); PG8_STAGE_A(PG8_SA(1, 0), last, kt2 + 1, 0); \
            PG8_WAIT_V(8); PG8_WAIT_L(0); PG8_BAR; MM(1, 0, At, B0); MM(1, 1, At, B1); PG8_BAR; PG8_SCHED;
    Unit cur, nxt; int ui = 0; int pend = -1;
    if (!S.next(0, cur)) return;
    f32x4 acc[2][2][4][2];
    typedef unsigned v8u_t __attribute__((ext_vector_type(8))); typedef int v8i_t __attribute__((ext_vector_type(8)));
    bf16x8 At[4][2], B0[2][2], B1[2][2]; v8u_t At8[4], B08[2], B18[2]; unsigned sc8 = 0x7f7f7f7fu; asm volatile("" : "+v"(sc8)); unsigned scA8 = OUT_SCA, scB8 = OUT_SCB; asm volatile("" : "+v"(scA8), "+v"(scB8));
    unsigned vc[2][2] = {{0u, 0u}, {0u, 0u}};
    size_t cA = S.a_tile(cur), nA = cA;
    if constexpr (Sched::FUSED) { S.a_wait(cur); PG8_SETB(cur); }
    PG8_VOFFS(vc, cur);
    { const char* bp0 = S.b_tile(cur, 0); const char* bp1 = S.b_tile(cur, 1);
      PG8_WAIT_L(0);
      PG8_STAGE_B(PG8_SB(0, 0), bp0, 0, false); PG8_STAGE_B(PG8_SB(0, 1), bp0, 1, false); PG8_STAGE_A(PG8_SA(0, 0), false, 0, 0); PG8_STAGE_A(PG8_SA(0, 1), false, 0, 1);
      if (wr == 1) PG8_BAR;
      PG8_WAIT_V(2); PG8_BAR;
      PG8_STAGE_B(PG8_SB(1, 0), bp1, 0, false); PG8_STAGE_A(PG8_SA(1, 0), false, 1, 0); PG8_STAGE_B(PG8_SB(1, 1), bp1, 1, false);
      PG8_WAIT_V(6); PG8_BAR; }
    { float zz = 0.f; asm volatile("" : "+v"(zz));
#pragma unroll
    for (int a = 0; a < 2; ++a)
#pragma unroll
        for (int b = 0; b < 2; ++b)
#pragma unroll
            for (int m = 0; m < 4; ++m)
#pragma unroll
                for (int n = 0; n < 2; ++n) acc[a][b][m][n] = (f32x4){zz, zz, zz, zz}; }
    for (;;) {
        const bool has_next = S.next(ui + 1, nxt);
        if (has_next) { nA = S.a_tile(nxt); } else { nxt = cur; nA = cA; }
        PG8_WAIT_L(0);
#define PG8_KLOOP(T0, T1, BODYSEL) _Pragma("unroll 1") for (int t = (T0); t < (T1); t += 2) { \
            const bool last = (t == nt - 2); \
            const int kt2 = last ? 0 : t + 2; \
            const char* b2 = last ? S.b_tile(nxt, 0) : S.b_tile(cur, kt2); \
            const char* b3 = last ? S.b_tile(nxt, 1) : S.b_tile(cur, kt2 + 1); \
            bool k82 = false; if constexpr (Sched::MIX) { k82 = !last && S.is8(kt2); } \
            BODYSEL; }
        if constexpr (Sched::MIX) { PG8_KLOOP(0, Sched::K8_0, PG8_BODY(PG8_MMAB)) PG8_KLOOP(Sched::K8_0, nt, PG8_BODY(PG8_MMA8S)) } else {
#pragma unroll 1
        for (int t = 0; t < nt; t += 2) {
            const bool last = (t == nt - 2);
            const int kt2 = last ? 0 : t + 2;
            const char* b2 = last ? S.b_tile(nxt, 0) : S.b_tile(cur, kt2);
            const char* b3 = last ? S.b_tile(nxt, 1) : S.b_tile(cur, kt2 + 1);
            bool m8 = false, k82 = false; if constexpr (Sched::MIX) { m8 = S.is8(t); k82 = !last && S.is8(kt2); }
            if constexpr (Sched::FUSED) { if (t == 2 && pend >= 0) { S.publish(pend, lane); pend = -1; }
                if (last && has_next) { S.a_wait(nxt); if (nxt.kind != cur.kind) PG8_SETB(nxt); } }
            PG8_BODY(PG8_MMA);
        } }
        if constexpr (ALIGN_EPI) { if (wr == 0) PG8_BAR; }
        if constexpr (FP8 || Sched::MIX) asm volatile("s_nop 15\n\ts_nop 15" ::: "memory");
        E(acc, cur, wr, wc, fr, fq);
        if constexpr (Sched::FUSED) { if (cur.kind == 0) pend = cur.pm; }
        if (!has_next) break;
        { float zz = 0.f; asm volatile("" : "+v"(zz));
#pragma unroll
        for (int a = 0; a < 2; ++a)
#pragma unroll
            for (int b = 0; b < 2; ++b)
#pragma unroll
                for (int m = 0; m < 4; ++m)
#pragma unroll
                    for (int n = 0; n < 2; ++n) acc[a][b][m][n] = (f32x4){zz, zz, zz, zz}; }
        cur = nxt; cA = nA; ++ui;
        if constexpr (ALIGN_EPI) { if (wr == 1) PG8_BAR; }
    }
    PG8_WAIT_V(0);
    if constexpr (Sched::FUSED) { if (pend >= 0) S.publish(pend, lane); }
    if constexpr (!ALIGN_EPI) { if (wr == 0) PG8_BAR; }
    PG8_BAR;
#undef PG8_SA
#undef PG8_SB
#undef PG8_STAGE_A
#undef PG8_STAGE_B
#undef PG8_LDA
#undef PG8_LDB
#undef PG8_MMA
#undef PG8_MMA8S
#undef PG8_PIN
#undef PG8_MMAB
#undef PG8_BODY
#undef PG8_KLOOP
#undef PG8_SUB0
#undef PG8_SUB1
#undef PG8_WAIT_V
#undef PG8_WAIT_L
#undef PG8_BAR
#undef PG8_SCHED
#undef PG8_VOFFS
#undef PG8_SETB
}
}
#ifndef FOX_FIXED_REF
#define FOX_FIXED_REF 1
#endif
#ifndef USE_NAIVE_SSD
#define USE_NAIVE_SSD 0
#endif
#ifndef USE_NAIVE_ATTN
#define USE_NAIVE_ATTN 0
#endif
#define GEMM_PHASE(F, Abase, nt, ldaB, ldbB, S, E) pg8::gemm_phase<__typeof__(E), __typeof__(S), true, false>(F.lds + RING_OFF, F.tid, Abase, nt, ldaB, ldbB, S, E)
#define GEMM_PHASE8(F, Abase, nt, ldaB, ldbB, S, E) pg8::gemm_phase<__typeof__(E), __typeof__(S), true, true>(F.lds + RING_OFF, F.tid, Abase, nt, ldaB, ldbB, S, E)

template <bool F8> struct EpiIn {
    static constexpr bool PERM = true;
    static constexpr float DS = F8 ? IN_DESCALE : 1.0f;
    bf16* U; float* FD;
    __device__ __forceinline__ void operator()(const f32x4 (&acc)[2][2][4][2], const Unit& u, int wr, int wc, int fr, int fq) const {
        const int row0 = u.pm * 256 + wr * 64 + fr;
        if (u.pn < 4) {
#pragma unroll
            for (int ai = 0; ai < 2; ++ai)
#pragma unroll
                for (int m = 0; m < 4; ++m) { bf16* rowp = U + (size_t)(row0 + ai * 128 + m * 16) * UP + UC_GLU + u.pn * 128 + wc * 16 + fq * 4;
#pragma unroll
                    for (int bj = 0; bj < 2; ++bj) { const f32x4 a = F8 ? acc[ai][bj][m][0] * DS : acc[ai][bj][m][0], g = F8 ? acc[ai][bj][m][1] * DS : acc[ai][bj][m][1];
                        v2u w; w.x = pk2(a[0] * sigmoidf_(g[0]), a[1] * sigmoidf_(g[1])); w.y = pk2(a[2] * sigmoidf_(g[2]), a[3] * sigmoidf_(g[3]));
                        *(v2u*)(rowp + bj * 64) = w; } }
        } else if (u.pn < 15) {
            const float sc = (u.pn < 6 ? C2 : 1.0f) * DS;
            const int col0 = 512 + (u.pn - 4) * 256 + wc * 32 + fq * 8;
#pragma unroll
            for (int ai = 0; ai < 2; ++ai)
#pragma unroll
                for (int m = 0; m < 4; ++m) { bf16* rowp = U + (size_t)(row0 + ai * 128 + m * 16) * UP + col0;
#pragma unroll
                    for (int bj = 0; bj < 2; ++bj) { const f32x4 v0 = acc[ai][bj][m][0] * sc, v1 = acc[ai][bj][m][1] * sc;
                        v4u w; w.x = pk2(v0[0], v0[1]); w.y = pk2(v0[2], v0[3]); w.z = pk2(v1[0], v1[1]); w.w = pk2(v1[2], v1[3]);
                        *(v4u*)(rowp + bj * 128) = w; } }
        } else {
            if (wc == 0 && fq < 2) {
#pragma unroll
                for (int ai = 0; ai < 2; ++ai)
#pragma unroll
                    for (int m = 0; m < 4; ++m) { float* rowp = FD + (size_t)(row0 + ai * 128 + m * 16) * 16 + fq * 8;
                        *(f32x4*)(rowp) = acc[ai][0][m][0] * DS; *(f32x4*)(rowp + 4) = acc[ai][0][m][1] * DS; }
            }
        }
    }
};
struct EpiOut {
    static constexpr bool PERM = false;
    const float* Xin; float* R;
    __device__ __forceinline__ void operator()(const f32x4 (&acc)[2][2][4][2], const Unit& u, int wr, int wc, int fr_, int fq_) const {
        int fr = fr_, fq = fq_; asm volatile("" : "+v"(fr), "+v"(fq));
        const int row0 = u.pm * 256 + wr * 64 + fr, col0 = u.pn * 256 + wc * 32 + fq * 4;
#pragma unroll
        for (int ai = 0; ai < 2; ++ai)
#pragma unroll
            for (int m = 0; m < 4; ++m) { const size_t off = (size_t)(row0 + ai * 128 + m * 16) * DM + col0;
#pragma unroll
                for (int bj = 0; bj < 2; ++bj)
#pragma unroll
                    for (int n = 0; n < 2; ++n) { const f32x4 x = *(const f32x4*)(Xin + off + bj * 128 + n * 16); *(f32x4*)(R + off + bj * 128 + n * 16) = x + acc[ai][bj][m][n]; } }
    }
};
template <bool WT> struct EpiGU_ {
    static constexpr bool PERM = true;
    bf16* H; const float* roww; const float* rstdv;
    __device__ __forceinline__ void operator()(const f32x4 (&acc)[2][2][4][2], const Unit& u, int wr, int wc, int fr, int fq) const {
        const int slot = u.pn >> 2;
        float w[2][4], rsd[2][4];
#pragma unroll
        for (int ai = 0; ai < 2; ++ai)
#pragma unroll
            for (int m = 0; m < 4; ++m) { const int grow = u.tb * 256 + ai * 128 + wr * 64 + m * 16 + fr; w[ai][m] = grow < u.cnt ? roww[((size_t)u.q * BCAP + grow) * 2 + slot] : 0.f; rsd[ai][m] = grow < u.cnt ? rstdv[(size_t)u.q * BCAP + grow] * MOE_GU_DESCALE : 0.f; }
#pragma unroll
        for (int ai = 0; ai < 2; ++ai)
#pragma unroll
            for (int m = 0; m < 4; ++m) { const int rloc = ai * 128 + wr * 64 + m * 16 + fr; const float ww = w[ai][m], rd = rsd[ai][m];
                unsigned char* rowp = (unsigned char*)H + (size_t)(u.pm * 256 + rloc) * 1024 + slot * 512 + (u.pn & 3) * 128 + wc * 16 + fq * 4;
#pragma unroll
                for (int bj = 0; bj < 2; ++bj) { const f32x4 g = acc[ai][bj][m][0] * rd, up = acc[ai][bj][m][1] * rd; const float w8 = ww * MOE_H_SCALE;
                    const float h0 = __builtin_amdgcn_fmed3f(siluf_(g[0]) * up[0] * w8, -448.f, 448.f), h1 = __builtin_amdgcn_fmed3f(siluf_(g[1]) * up[1] * w8, -448.f, 448.f), h2 = __builtin_amdgcn_fmed3f(siluf_(g[2]) * up[2] * w8, -448.f, 448.f), h3 = __builtin_amdgcn_fmed3f(siluf_(g[3]) * up[3] * w8, -448.f, 448.f);
                    int o = 0; o = __builtin_amdgcn_cvt_pk_fp8_f32(h0, h1, o, false); o = __builtin_amdgcn_cvt_pk_fp8_f32(h2, h3, o, true);
                    if (WT) __hip_atomic_store((unsigned*)(rowp + bj * 64), (unsigned)o, RLX_AGENT); else *(int*)(rowp + bj * 64) = o; } }
    }
};
typedef EpiGU_<false> EpiGU;
struct EpiDown {
    static constexpr bool PERM = false;
    float* R; const int* perm; const LAS int* tokl;
    __device__ __forceinline__ void operator()(const f32x4 (&acc)[2][2][4][2], const Unit& u, int wr, int wc, int fr_, int fq) const {
        int fr = fr_; asm volatile("" : "+v"(fr));
        const int col0 = u.pn * 256 + wc * 32 + fq * 4;
#pragma unroll
        for (int ai = 0; ai < 2; ++ai)
#pragma unroll
            for (int m = 0; m < 4; ++m) { const int rloc = ai * 128 + wr * 64 + m * 16 + fr, grow = u.tb * 256 + rloc;
                if (grow < u.cnt) { const int tok = u.ord < TOK_UNITS ? tokl[u.ord * 256 + rloc] : perm[u.q * BCAP + grow]; float* rp = R + (size_t)tok * DM + col0;
#pragma unroll
                    for (int bj = 0; bj < 2; ++bj)
#pragma unroll
                        for (int n = 0; n < 2; ++n) { const f32x4 x = *(const f32x4*)(rp + bj * 128 + n * 16); *(f32x4*)(rp + bj * 128 + n * 16) = x + acc[ai][bj][m][n] * MOE_DN_DESCALE; } } }
    }
};

struct EpiF {
    static constexpr bool PERM = true;
    EpiGU_<true> gu; EpiDown dn; gu32* rdy;
    __device__ __forceinline__ void operator()(const f32x4 (&acc)[2][2][4][2], const Unit& u, int wr, int wc, int fr, int fq) const {
        if (u.kind == 0) gu(acc, u, wr, wc, fr, fq);
        else dn(acc, u, wr, wc, fr, fq);
    }
};

template <class Src>
__device__ __forceinline__ void transpose_item(const Src& src, bf16* WT, int Kd, LAS float* scr, int k0, int n0, int lane) {
    { f32x4 t4[8];
#pragma unroll
        for (int i = 0; i < 8; ++i) t4[i] = src.load4(k0 + 8 * i + (lane >> 3), n0 + 4 * (lane & 7));
#pragma unroll
        for (int i = 0; i < 8; ++i) { LAS float* d = scr + (8 * i + (lane >> 3)) * 33 + 4 * (lane & 7); d[0] = t4[i].x; d[1] = t4[i].y; d[2] = t4[i].z; d[3] = t4[i].w; } }
    LDS_WAIT(); asm volatile("" ::: "memory");
    const int c = lane & 7;
#pragma unroll
    for (int j = 0; j < 4; ++j) { const int n = (lane >> 3) + 8 * j; const LAS float* s = scr + (8 * c) * 33 + n;
        v4u o; o.x = pk2(s[0 * 33], s[1 * 33]); o.y = pk2(s[2 * 33], s[3 * 33]); o.z = pk2(s[4 * 33], s[5 * 33]); o.w = pk2(s[6 * 33], s[7 * 33]);
        *(v4u*)(WT + (size_t)(n0 + n) * Kd + k0 + 8 * c) = o; }
    LDS_WAIT(); asm volatile("" ::: "memory");
}
template <class Src>
__device__ __forceinline__ void transpose_item8(const Src& src, unsigned char* WT, int Kd, float scale, LAS float* scr, int k0, int n0, int lane) {
    { f32x4 t4[8];
#pragma unroll
        for (int i = 0; i < 8; ++i) t4[i] = src.load4(k0 + 8 * i + (lane >> 3), n0 + 4 * (lane & 7));
#pragma unroll
        for (int i = 0; i < 8; ++i) { LAS float* d = scr + (8 * i + (lane >> 3)) * 33 + 4 * (lane & 7); d[0] = t4[i].x; d[1] = t4[i].y; d[2] = t4[i].z; d[3] = t4[i].w; } }
    LDS_WAIT(); asm volatile("" ::: "memory");
    const int n = lane >> 1, kh = (lane & 1) * 32; const LAS float* sp = scr + kh * 33 + n;
    int w[8];
#pragma unroll
    for (int j = 0; j < 8; ++j) { int o = 0; o = __builtin_amdgcn_cvt_pk_fp8_f32(sp[(4 * j) * 33] * scale, sp[(4 * j + 1) * 33] * scale, o, false); o = __builtin_amdgcn_cvt_pk_fp8_f32(sp[(4 * j + 2) * 33] * scale, sp[(4 * j + 3) * 33] * scale, o, true); w[j] = o; }
    unsigned char* dp = WT + (size_t)(n0 + n) * Kd + k0 + kh;
    *(v4u*)dp = (v4u){(unsigned)w[0], (unsigned)w[1], (unsigned)w[2], (unsigned)w[3]}; *(v4u*)(dp + 16) = (v4u){(unsigned)w[4], (unsigned)w[5], (unsigned)w[6], (unsigned)w[7]};
    LDS_WAIT(); asm volatile("" ::: "memory");
}
__device__ __forceinline__ int win_src_col(int v) {
    if (v < 1024) { const int i = v >> 3, j = v & 7; return j < 4 ? 4 * i + j : 512 + 4 * i + (j - 4); }
    if (v < 3840) { const int o = v - 1024; return o < 1536 ? 1024 + o : 2568 + (o - 1536); }
    if (v < 3848) return 2560 + (v - 3840);
    if (v < 3856) return v;
    return -1;
}
struct SrcWin { const float* W; __device__ __forceinline__ f32x4 load4(int k, int v) const { const int c = win_src_col(v); return c < 0 ? (f32x4){0.f, 0.f, 0.f, 0.f} : *(const f32x4*)(W + (size_t)k * D_IN + c); } };
struct SrcPlain { const float* W; int N; __device__ __forceinline__ f32x4 load4(int k, int n) const { return *(const f32x4*)(W + (size_t)k * N + n); } };
struct SrcGU { const float* Wg; const float* Wu; __device__ __forceinline__ f32x4 load4(int k, int v) const { const int i = v >> 3; return (v & 4) ? *(const f32x4*)(Wu + (size_t)k * DEXP + 4 * i) : *(const f32x4*)(Wg + (size_t)k * DEXP + 4 * i); } };

template <bool FINAL>
__device__ __forceinline__ void norm_rows_t(Frame& F, const float* X, const float* gain, bf16* XN, unsigned char* XN8, float* out) {
    f32x4 g[4];
#pragma unroll
    for (int j = 0; j < 4; ++j) g[j] = *((const f32x4*)gain + F.lane + 64 * j);
    const int gw = F.vcu * 8 + F.wave, NGW = F.G * 8;
    f32x4 v[4], vn[4];
    if (gw < M) {
#pragma unroll
        for (int j = 0; j < 4; ++j) v[j] = *((const f32x4*)(X + (size_t)gw * DM) + F.lane + 64 * j); }
    for (int m = gw; m < M; m += NGW) {
        const int mn = m + NGW;
        if (mn < M) {
#pragma unroll
            for (int j = 0; j < 4; ++j) vn[j] = *((const f32x4*)(X + (size_t)mn * DM) + F.lane + 64 * j); }
        float s = 0.f;
#pragma unroll
        for (int j = 0; j < 4; ++j) s += (v[j].x * v[j].x + v[j].y * v[j].y) + (v[j].z * v[j].z + v[j].w * v[j].w);
        const float rstd = __builtin_amdgcn_rsqf(wave_sum(s) * (1.f / DM) + EPS);
        if (FINAL) { f32x4* o = (f32x4*)(out + (size_t)m * DM) + F.lane;
#pragma unroll
            for (int j = 0; j < 4; ++j) o[64 * j] = v[j] * rstd * g[j];
        } else { unsigned long long* o8 = (unsigned long long*)(XN + (size_t)m * DM) + F.lane;
#pragma unroll
            for (int j = 0; j < 4; ++j) { const f32x4 w = v[j] * rstd * g[j]; o8[64 * j] = (unsigned long long)pk2(w.x, w.y) | ((unsigned long long)pk2(w.z, w.w) << 32); }
            int* o4 = (int*)(XN8 + (size_t)m * DM) + F.lane;
#pragma unroll
            for (int j = 0; j < 4; ++j) { const f32x4 w = v[j] * (rstd * IN_X_SCALE) * g[j]; int o = 0; o = __builtin_amdgcn_cvt_pk_fp8_f32(w.x, w.y, o, false); o = __builtin_amdgcn_cvt_pk_fp8_f32(w.z, w.w, o, true); o4[64 * j] = o; } }
#pragma unroll
        for (int j = 0; j < 4; ++j) v[j] = vn[j];
    }
}
__device__ __forceinline__ void norm_rows_phase(Frame& F, const float* X, const float* gain, bf16* XN, unsigned char* XN8) { norm_rows_t<false>(F, X, gain, XN, XN8, nullptr); }
__device__ __forceinline__ void final_norm_phase(Frame& F, const float* X, const float* gain, float* out) { norm_rows_t<true>(F, X, gain, nullptr, nullptr, out); }
struct PItem { const float* src; int ld; bool zero, fp8; unsigned char* dst; int Kd; float scale; };
__device__ __forceinline__ void pitem_decode(Frame& F, unsigned char* ws, int it, PItem& p) {
    constexpr int I_IN = 16 * 64, I_OUT = 24 * 16, I_GU = 16 * 16, I_D = 8 * 16;
    constexpr int N_IN = DEPTH * I_IN, N_OUT = DEPTH * I_OUT, N_GU = DEPTH * NEXP * I_GU;
    const int nq4 = 4 * (F.lane & 15), kq = F.lane >> 4; int r = it; p.zero = false; p.scale = 1.f;
    if (r < N_IN) { const int l = r / I_IN, j = r % I_IN, k0 = (j / 64) * 64, n0 = (j % 64) * 64; const int c = win_src_col(n0 + nq4);
        p.zero = c < 0; p.ld = D_IN; p.src = inptr(F, 2) + (size_t)l * DM * D_IN + (size_t)(k0 + kq) * D_IN + (c < 0 ? 0 : c);
        if (n0 < NT8 * 256) { p.fp8 = true; p.Kd = DM; p.scale = IN_W_SCALE; p.dst = ws + WS_WIN8 + (size_t)l * NV_IN * DM + (size_t)n0 * DM + k0; return; }
        p.fp8 = false; p.Kd = DM; p.dst = ws + WS_WIN + ((size_t)l * NV_IN * DM + (size_t)n0 * DM + k0) * 2; return; }
    r -= N_IN;
    if (r < N_OUT) { const int l = r / I_OUT, j = r % I_OUT, k0 = (j / 16) * 64, n0 = (j % 16) * 64;
        p.ld = DM; p.src = inptr(F, 14) + (size_t)l * D_MIX * DM + (size_t)(k0 + kq) * DM + n0 + nq4;
        if (k0 >= 512 && k0 < 1024) { p.fp8 = true; p.Kd = 512; p.scale = OUT_W_SCALE; p.dst = ws + WS_WOUT8 + (size_t)l * DM * 512 + (size_t)n0 * 512 + (k0 - 512); return; }
        p.fp8 = false; p.Kd = D_MIX; p.dst = ws + WS_WOUT + ((size_t)l * DM * D_MIX + (size_t)n0 * D_MIX + k0) * 2; return; }
    r -= N_OUT;
    if (r < N_GU) { const int le = r / I_GU, j = r % I_GU, k0 = (j / 16) * 64, n0 = (j % 16) * 64; const int v = n0 + nq4;
        p.ld = DEXP; p.src = ((v & 4) ? inptr(F, 21) : inptr(F, 20)) + (size_t)le * DM * DEXP + (size_t)(k0 + kq) * DEXP + 4 * (v >> 3);
        p.fp8 = true; p.Kd = 1024; p.scale = MOE_WGU_SCALE; p.dst = ws + WS_WGU + (size_t)le * 1024 * 1024 + (size_t)n0 * 1024 + k0; return; }
    r -= N_GU;
    { const int le = r / I_D, j = r % I_D, k0 = (j / 16) * 64, n0 = (j % 16) * 64;
        p.ld = DM; p.src = inptr(F, 22) + (size_t)le * DEXP * DM + (size_t)(k0 + kq) * DM + n0 + nq4;
        p.fp8 = true; p.Kd = 512; p.scale = MOE_WD_SCALE; p.dst = ws + WS_WD + (size_t)le * 1024 * 512 + (size_t)n0 * 512 + k0; }
}
__device__ __forceinline__ void pitem_load(const PItem& p, f32x4 (&t4)[16]) {
#pragma unroll
    for (int i = 0; i < 16; ++i) { t4[i] = (f32x4){0.f, 0.f, 0.f, 0.f}; if (!p.zero) t4[i] = *(const f32x4*)(p.src + (size_t)(4 * i) * p.ld); }
}
__device__ __forceinline__ void convert_items(Frame& F, unsigned char* ws, LAS float* scr, const int gw, const int NGW, const int NITEMS) {
    const int lane = F.lane;
    PItem cur; f32x4 t4[16];
    if (gw < NITEMS) { pitem_decode(F, ws, gw, cur); pitem_load(cur, t4); }
    for (int it = gw; it < NITEMS; it += NGW) {
#pragma unroll
        for (int hf = 0; hf < 2; ++hf) {
            if (((lane >> 3) & 1) == hf) {
#pragma unroll
                for (int i = 0; i < 16; ++i) { LAS float* d = scr + (4 * i + (lane >> 4)) * 33 + 4 * (lane & 7); d[0] = t4[i].x; d[1] = t4[i].y; d[2] = t4[i].z; d[3] = t4[i].w; } }
            LDS_WAIT(); asm volatile("" ::: "memory");
            if (!cur.fp8) { const int c = lane & 7;
#pragma unroll
                for (int j = 0; j < 4; ++j) { const int n = (lane >> 3) + 8 * j; const LAS float* s = scr + (8 * c) * 33 + n;
                    v4u o; o.x = pk2(s[0 * 33], s[1 * 33]); o.y = pk2(s[2 * 33], s[3 * 33]); o.z = pk2(s[4 * 33], s[5 * 33]); o.w = pk2(s[6 * 33], s[7 * 33]);
                    *(v4u*)(cur.dst + ((size_t)(32 * hf + n) * cur.Kd + 8 * c) * 2) = o; }
            } else { const int n = lane >> 1, kh = (lane & 1) * 32; const LAS float* sp = scr + kh * 33 + n; const float scale = cur.scale; int w[8];
#pragma unroll
                for (int j = 0; j < 8; ++j) { int o = 0; o = __builtin_amdgcn_cvt_pk_fp8_f32(sp[(4 * j) * 33] * scale, sp[(4 * j + 1) * 33] * scale, o, false); o = __builtin_amdgcn_cvt_pk_fp8_f32(sp[(4 * j + 2) * 33] * scale, sp[(4 * j + 3) * 33] * scale, o, true); w[j] = o; }
                unsigned char* dp = cur.dst + (size_t)(32 * hf + n) * cur.Kd + kh;
                *(v4u*)dp = (v4u){(unsigned)w[0], (unsigned)w[1], (unsigned)w[2], (unsigned)w[3]}; *(v4u*)(dp + 16) = (v4u){(unsigned)w[4], (unsigned)w[5], (unsigned)w[6], (unsigned)w[7]}; }
            LDS_WAIT(); asm volatile("" ::: "memory");
        }
        if (it + NGW < NITEMS) { pitem_decode(F, ws, it + NGW, cur); pitem_load(cur, t4); }
    }
}
constexpr int PITEMS_DENSE = DEPTH * (16 * 64 + 24 * 16), PITEMS_MOE = DEPTH * NEXP * (16 * 16 + 8 * 16);
__device__ __forceinline__ void prologue_phase(Frame& F, unsigned char* ws) {
    convert_items(F, ws, (LAS float*)(F.lds + RING_OFF + F.wave * 16384), F.vcu * 8 + F.wave, F.G * 8, PITEMS_DENSE);
    norm_rows_phase(F, inptr(F, 0), inptr(F, 1), (bf16*)(ws + WS_XN), ws + WS_XN8);
}

struct MoeConvExtra {
    Frame* F; unsigned char* ws;
    static constexpr int NCH = PITEMS_MOE / 96, GRP = 5;
    __device__ __forceinline__ int total(int natt) const { return natt + NCH; }
    __device__ __forceinline__ bool map(int L, int& idx) const { if (L < NCH * GRP) { const int g = L / GRP, r = L % GRP; if (r == GRP - 1) { idx = g; return true; } idx = g * (GRP - 1) + r; return false; } idx = L - NCH; return false; }
    __device__ __forceinline__ void run(int chunk) const { Frame& f = *F; relaunder(f); const int base = PITEMS_DENSE + chunk * 96 + f.wave * 12;
        convert_items(f, ws, (LAS float*)(f.lds + RING_OFF + f.wave * 12288), base, 1, base + 12); }
};
struct NoExtra {
    __device__ __forceinline__ int total(int natt) const { return natt; }
    __device__ __forceinline__ bool map(int L, int& idx) const { idx = L; return false; }
    __device__ __forceinline__ void run(int) const {}
};
static_assert(PITEMS_MOE % 96 == 0, "expert weight items must split into whole chunks");

__device__ __forceinline__ float log_sigmoidf_(float x) { return fminf(x, 0.f) - log1pf(__expf(-fabsf(x))); }
constexpr float ATT_SKIP_NATS = 140.f;
__device__ __forceinline__ void fcum_unit(Frame& F, int bh, const float* FD, const float* fb, float* FC, int* TS) {
    relaunder(F);
    const int b = bh >> 3, h = bh & 7; const float bias = fb[h];
    LAS float* ws = (LAS float*)(F.lds);
    float v[8]; float run = 0.f;
#pragma unroll
    for (int i = 0; i < 8; ++i) { const int t = F.tid * 8 + i; run += log_sigmoidf_(FD[((size_t)b * SEQ + t) * 16 + h] + bias); v[i] = run; }
    float inc = run;
#pragma unroll
    for (int o = 1; o < 64; o <<= 1) { const float t = __builtin_bit_cast(float, __builtin_amdgcn_ds_bpermute(((F.lane - o) & 63) << 2, __builtin_bit_cast(int, inc))); if (F.lane >= o) inc += t; }
    __syncthreads();
    if (F.lane == 63) ws[F.wave] = inc;
    __syncthreads();
    float base = inc - run;
    for (int w = 0; w < F.wave; ++w) base += ws[w];
#pragma unroll
    for (int i = 0; i < 8; ++i) FC[(size_t)bh * SEQ + F.tid * 8 + i] = base + v[i];
    if ((F.tid & 7) == 7) ws[16 + (F.tid >> 3)] = base + v[7];
    __syncthreads();
    if (F.tid < 16) { const int qb = F.tid; const float cl = ws[16 + 4 * qb + 3]; int n = 0;
        for (int t = 0; t < 4 * qb; ++t) n += (cl - ws[16 + t] < -ATT_SKIP_NATS) ? 1 : 0;
        TS[bh * 16 + qb] = n & ~1; }
    __syncthreads();
}
__device__ __forceinline__ void conv_unit(Frame& F, int unit, const bf16* U, const float* dww, const float* dwb, const float* lng, const float* lnb, bf16* Y) {
    relaunder(F);
    const int b = unit >> 7, t0 = (unit & 127) * 32;
    LAS bf16* Gs = (LAS bf16*)(F.lds);
    LAS float* Ys = (LAS float*)(F.lds + 63488);
    __syncthreads();
    for (int c = F.tid; c < 62 * 64; c += 512) { const int r = c >> 6, ch = c & 63, t = t0 - 30 + r;
        v4u v = (v4u){0u, 0u, 0u, 0u}; if (t >= 0) v = *(const v4u*)(U + ((size_t)b * SEQ + t) * UP + UC_GLU + ch * 8);
        *(LAS v4u*)(Gs + r * 512 + ch * 8) = v; }
    __syncthreads();
    { const int ch = F.tid; float w[31];
#pragma unroll
        for (int k = 0; k < 31; ++k) { const GAS float* wp = (const GAS float*)dww + k * 512 + ch; asm volatile("" : "+v"(wp)); w[k] = *wp; }
        const float bias = dwb[ch];
        float g[62];
#pragma unroll
        for (int r = 0; r < 62; ++r) g[r] = bf2f(Gs[r * 512 + ch]);
#pragma unroll
        for (int tt = 0; tt < 32; ++tt) { float y = bias;
#pragma unroll
            for (int k = 0; k < 31; ++k) y += w[k] * g[tt + k];
            Ys[tt * 512 + ch] = y; } }
    __syncthreads();
    { const int ch0 = F.lane * 8;
        f32x4 ga = *(const f32x4*)(lng + ch0), gb = *(const f32x4*)(lng + ch0 + 4), ba = *(const f32x4*)(lnb + ch0), bb = *(const f32x4*)(lnb + ch0 + 4);
#pragma unroll
        for (int i = 0; i < 4; ++i) { const int tt = F.wave * 4 + i;
            f32x4 a = *(const LAS f32x4*)(Ys + tt * 512 + ch0), c = *(const LAS f32x4*)(Ys + tt * 512 + ch0 + 4);
            const float mu = wave_sum((a.x + a.y) + (a.z + a.w) + (c.x + c.y) + (c.z + c.w)) * (1.f / 512);
            a = a - mu; c = c - mu;
            const float var = wave_sum((a.x * a.x + a.y * a.y) + (a.z * a.z + a.w * a.w) + (c.x * c.x + c.y * c.y) + (c.z * c.z + c.w * c.w)) * (1.f / 512);
            const float rstd = __builtin_amdgcn_rsqf(var + EPS);
            a = a * rstd * ga + ba; c = c * rstd * gb + bb;
            v4u o; o.x = pk2(siluf_(a.x), siluf_(a.y)); o.y = pk2(siluf_(a.z), siluf_(a.w)); o.z = pk2(siluf_(c.x), siluf_(c.y)); o.w = pk2(siluf_(c.z), siluf_(c.w));
            *(v4u*)(Y + ((size_t)b * SEQ + t0 + tt) * YP + YC_CONV + ch0) = o; } }
}

__device__ __forceinline__ void conv_units(Frame& F, int first, int nunits, const bf16* U, const float* dww, const float* dwb, const float* lng, const float* lnb, bf16* Y) {
    relaunder(F);
    LAS bf16* Gs = (LAS bf16*)(F.lds);
    LAS float* Ys = (LAS float*)(F.lds + 63488);
    const int ch = F.tid;
    float w[31];
#pragma unroll
    for (int k = 0; k < 31; ++k) w[k] = dww[k * 512 + ch];
    const float bias = dwb[ch];
    const int ch0 = F.lane * 8;
    const f32x4 ga = *(const f32x4*)(lng + ch0), gb = *(const f32x4*)(lng + ch0 + 4), ba = *(const f32x4*)(lnb + ch0), bb = *(const f32x4*)(lnb + ch0 + 4);
    v4u pre[8];
#define CONV_LOAD(unit) do { const int b_ = (unit) >> 7, t0_ = ((unit) & 127) * 32; _Pragma("unroll") for (int j = 0; j < 8; ++j) { const int c = F.tid + 512 * j; const int r = c >> 6, cc = c & 63, t = t0_ - 30 + r; \
        pre[j] = (v4u){0u, 0u, 0u, 0u}; if (c < 62 * 64 && t >= 0) pre[j] = *(const v4u*)(U + ((size_t)b_ * SEQ + t) * UP + UC_GLU + cc * 8); } } while (0)
    if (first < nunits) CONV_LOAD(first);
    for (int unit = first; unit < nunits; unit += F.G) {
        const int b = unit >> 7, t0 = (unit & 127) * 32;
        __syncthreads();
#pragma unroll
        for (int j = 0; j < 8; ++j) { const int c = F.tid + 512 * j; if (c < 62 * 64) *(LAS v4u*)(Gs + (c >> 6) * 512 + (c & 63) * 8) = pre[j]; }
        __syncthreads();
        if (unit + F.G < nunits) CONV_LOAD(unit + F.G);
        { float g[62];
#pragma unroll
            for (int r = 0; r < 62; ++r) g[r] = bf2f(Gs[r * 512 + ch]);
#pragma unroll
            for (int tt = 0; tt < 32; ++tt) { float y = bias;
#pragma unroll
                for (int k = 0; k < 31; ++k) y += w[k] * g[tt + k];
                Ys[tt * 512 + ch] = y; } }
        __syncthreads();
#pragma unroll
        for (int i = 0; i < 4; ++i) { const int tt = F.wave * 4 + i;
            f32x4 a = *(const LAS f32x4*)(Ys + tt * 512 + ch0), c = *(const LAS f32x4*)(Ys + tt * 512 + ch0 + 4);
            const float mu = wave_sum((a.x + a.y) + (a.z + a.w) + (c.x + c.y) + (c.z + c.w)) * (1.f / 512);
            a = a - mu; c = c - mu;
            const float var = wave_sum((a.x * a.x + a.y * a.y) + (a.z * a.z + a.w * a.w) + (c.x * c.x + c.y * c.y) + (c.z * c.z + c.w * c.w)) * (1.f / 512);
            const float rstd = __builtin_amdgcn_rsqf(var + EPS);
            a = a * rstd * ga + ba; c = c * rstd * gb + bb;
            v4u o; o.x = pk2(siluf_(a.x), siluf_(a.y)); o.y = pk2(siluf_(a.z), siluf_(a.w)); o.z = pk2(siluf_(c.x), siluf_(c.y)); o.w = pk2(siluf_(c.z), siluf_(c.w));
            *(v4u*)(Y + ((size_t)b * SEQ + t0 + tt) * YP + YC_CONV + ch0) = o; }
    }
#undef CONV_LOAD
    __syncthreads();
}

__device__ __forceinline__ float softplusf_(float x) { return x > 20.f ? x : log1pf(__expf(x)); }
__device__ __forceinline__ void ssd_seq_unit(Frame& F, int unit, const bf16* U, const float* FD, bf16* Y, const float* cw, const float* cb, const float* dtbias, const float* Alog, const float* Dsk) {
    relaunder(F);
    const int b = unit >> 1, g = unit & 1, h = g * 4 + (F.wave >> 1), p = (F.wave & 1) * 32 + (F.lane >> 1), nh = F.lane & 1;
    LAS float* bc = (LAS float*)(F.lds) + F.wave * 128;
    const int chx = h * 64 + p, chB = 512 + g * 64 + F.lane, chC = 640 + g * 64 + F.lane;
    float wx[4], wB[4], wC[4];
#pragma unroll
    for (int k = 0; k < 4; ++k) { wx[k] = cw[k * 768 + chx]; wB[k] = cw[k * 768 + chB]; wC[k] = cw[k * 768 + chC]; }
    const float bx = cb[chx], bB = cb[chB], bC = cb[chC];
    const float dtb = dtbias[h], A = -__expf(Alog[h]), Dh = Dsk[h];
    float hs[32];
#pragma unroll
    for (int n = 0; n < 32; ++n) hs[n] = 0.f;
    float x1 = 0.f, x2 = 0.f, x3 = 0.f, B1 = 0.f, B2 = 0.f, B3 = 0.f, C1 = 0.f, C2_ = 0.f, C3 = 0.f;
    const bf16* Ub = U + (size_t)b * SEQ * UP; const float* FDb = FD + (size_t)b * SEQ * 16;
    float rx[4], rB[4], rC[4], rz[4], rd[4];
#pragma unroll
    for (int i = 0; i < 4; ++i) { const bf16* ur = Ub + (size_t)i * UP; rx[i] = bf2f(ur[UC_XS + chx]); rB[i] = bf2f(ur[UC_XS + chB]); rC[i] = bf2f(ur[UC_XS + chC]); rz[i] = bf2f(ur[UC_Z + chx]); rd[i] = FDb[(size_t)i * 16 + 8 + h]; }
#pragma unroll 1
    for (int tb = 0; tb < SEQ; tb += 4) {
        float nx[4], nB[4], nC[4], nz[4], nd[4];
#pragma unroll
        for (int i = 0; i < 4; ++i) { int t = tb + 4 + i; t = t < SEQ ? t : SEQ - 1; const bf16* ur = Ub + (size_t)t * UP;
            nx[i] = bf2f(ur[UC_XS + chx]); nB[i] = bf2f(ur[UC_XS + chB]); nC[i] = bf2f(ur[UC_XS + chC]); nz[i] = bf2f(ur[UC_Z + chx]); nd[i] = FDb[(size_t)t * 16 + 8 + h]; }
#pragma unroll
        for (int i = 0; i < 4; ++i) {
            const float x0 = rx[i], B0 = rB[i], C0 = rC[i];
            const float xc = siluf_(wx[0] * x3 + wx[1] * x2 + wx[2] * x1 + wx[3] * x0 + bx);
            const float Bv = siluf_(wB[0] * B3 + wB[1] * B2 + wB[2] * B1 + wB[3] * B0 + bB);
            const float Cv = siluf_(wC[0] * C3 + wC[1] * C2_ + wC[2] * C1 + wC[3] * C0 + bC);
            x3 = x2; x2 = x1; x1 = x0; B3 = B2; B2 = B1; B1 = B0; C3 = C2_; C2_ = C1; C1 = C0;
            const float dt = softplusf_(rd[i] + dtb), dA = __expf(dt * A), xdt = xc * dt;
            asm volatile("" ::: "memory");
            bc[F.lane] = Bv; bc[64 + F.lane] = Cv;
            LDS_WAIT(); asm volatile("" ::: "memory");
            float y = 0.f;
#pragma unroll
            for (int n4 = 0; n4 < 8; ++n4) { const f32x4 bb = *(const LAS f32x4*)(bc + nh * 32 + n4 * 4), cc = *(const LAS f32x4*)(bc + 64 + nh * 32 + n4 * 4);
                hs[n4 * 4 + 0] = hs[n4 * 4 + 0] * dA + bb.x * xdt; y += cc.x * hs[n4 * 4 + 0];
                hs[n4 * 4 + 1] = hs[n4 * 4 + 1] * dA + bb.y * xdt; y += cc.y * hs[n4 * 4 + 1];
                hs[n4 * 4 + 2] = hs[n4 * 4 + 2] * dA + bb.z * xdt; y += cc.z * hs[n4 * 4 + 2];
                hs[n4 * 4 + 3] = hs[n4 * 4 + 3] * dA + bb.w * xdt; y += cc.w * hs[n4 * 4 + 3]; }
            LDS_WAIT(); asm volatile("" ::: "memory");
            y += DPP_F(y, 0xB1);
            y += Dh * xc;
            const float yz = y * siluf_(rz[i]);
            if (nh == 0) Y[((size_t)b * SEQ + tb + i) * YP + YC_SSD + chx] = (bf16)f2bf(yz);
        }
#pragma unroll
        for (int i = 0; i < 4; ++i) { rx[i] = nx[i]; rB[i] = nB[i]; rC[i] = nC[i]; rz[i] = nz[i]; rd[i] = nd[i]; }
    }
}

constexpr size_t WS_CD = 163 * MiB;
constexpr size_t WS_HPB = 469 * MiB;
constexpr int SSD_XT = 0, SSD_B = 69632, SSD_C = 88064, SSD_DT = 106496, SSD_AC = 110592, SSD_ACT = 114688;
constexpr int XTS = 136, BCS = 72;
typedef float f32x16 __attribute__((ext_vector_type(16)));
__device__ __forceinline__ int crow16(int reg, int hi) { return (reg & 3) + 8 * (reg >> 2) + 4 * hi; }
#define MFMA32(a, b, c) __builtin_amdgcn_mfma_f32_32x32x16_bf16((a), (b), (c), 0, 0, 0)
__device__ __forceinline__ void ssd_scalars(Frame& F, int b, int c, const float* FD, const float* dtbias, const float* Alog) {
    LAS float* dts = (LAS float*)(F.lds + SSD_DT); LAS float* acs = (LAS float*)(F.lds + SSD_AC); LAS float* acT = (LAS float*)(F.lds + SSD_ACT);
    __syncthreads();
    { const int t = F.tid >> 2, hp = F.tid & 3; const size_t row = (size_t)b * SEQ + c * 128 + t;
#pragma unroll
        for (int k = 0; k < 2; ++k) { const int h = hp * 2 + k; const float dt = softplusf_(FD[row * 16 + 8 + h] + dtbias[h]); dts[t * 8 + h] = dt; acs[t * 8 + h] = -__expf(Alog[h]) * dt; } }
    __syncthreads();
    { const int h = F.wave; const float v0 = acs[(2 * F.lane) * 8 + h], v1 = acs[(2 * F.lane + 1) * 8 + h], sm = v0 + v1; float inc = sm;
#pragma unroll
        for (int o = 1; o < 64; o <<= 1) { const float tt = __builtin_bit_cast(float, __builtin_amdgcn_ds_bpermute(((F.lane - o) & 63) << 2, __builtin_bit_cast(int, inc))); if (F.lane >= o) inc += tt; }
        const float ex = inc - sm, a0 = ex + v0, a1 = ex + sm;
        acs[(2 * F.lane) * 8 + h] = a0; acs[(2 * F.lane + 1) * 8 + h] = a1; acT[h * 128 + 2 * F.lane] = a0; acT[h * 128 + 2 * F.lane + 1] = a1; }
    __syncthreads();
}
__device__ __forceinline__ float bf_of(const v4u& v, int j) { const unsigned w = j < 2 ? v.x : (j < 4 ? v.y : (j < 6 ? v.z : v.w)); return (j & 1) ? bfhi(w) : bflo(w); }
__device__ __forceinline__ void ssd_load_raw(v4u (&raw)[11], int b, int c, int tr, int ch768, const bf16* U) {
#pragma unroll
    for (int i = 0; i < 11; ++i) { const int tg = c * 128 + tr * 8 - 3 + i; raw[i] = (v4u){0u, 0u, 0u, 0u}; if (tg >= 0) raw[i] = *(const v4u*)(U + ((size_t)b * SEQ + tg) * UP + UC_XS + ch768); }
}
template <bool XS> __device__ __forceinline__ bool ssd_T_active(const Frame& F) { return XS || F.tid < 128; }
template <bool XS> __device__ __forceinline__ int ssd_T_tr(const Frame& F) { return XS ? (F.tid >> 5) : (F.tid >> 3); }
template <bool XS> __device__ __forceinline__ int ssd_T_ch(const Frame& F, int g) { const int cg = F.tid & (XS ? 31 : 7); return XS ? g * 256 + cg * 8 : 512 + g * 64 + cg * 8; }
template <bool XS>
__device__ __forceinline__ void ssd_stage_T(Frame& F, const v4u (&raw)[11], int g, const float* cw, const float* cb, bool passA) {
    if (!ssd_T_active<XS>(F)) return;
    const int ncg = XS ? 32 : 8;
    const int cg = F.tid & (ncg - 1), tr = ssd_T_tr<XS>(F);
    const int ch768 = ssd_T_ch<XS>(F, g);
    const int h = g * 4 + (cg >> 3);
    LAS float* dts = (LAS float*)(F.lds + SSD_DT); LAS float* acs = (LAS float*)(F.lds + SSD_AC);
    const float aend = acs[127 * 8 + h];
    float sc[8];
#pragma unroll
    for (int m = 0; m < 8; ++m) { const int tt = tr * 8 + m; sc[m] = 1.f; if (XS) { sc[m] = dts[tt * 8 + h]; if (passA) sc[m] *= __expf(aend - acs[tt * 8 + h]); } }
    LAS unsigned char* dst = F.lds + (XS ? SSD_XT : SSD_B);
#pragma unroll
    for (int j = 0; j < 8; ++j) {
        const float k0 = cw[ch768 + j], k1 = cw[768 + ch768 + j], k2 = cw[2 * 768 + ch768 + j], k3 = cw[3 * 768 + ch768 + j], bb = cb[ch768 + j];
        float xw[11]; unsigned o[4];
#pragma unroll
        for (int i = 0; i < 11; ++i) xw[i] = bf_of(raw[i], j);
#pragma unroll
        for (int m = 0; m < 8; m += 2) {
            const float v0 = siluf_(__builtin_fmaf(k0, xw[m], __builtin_fmaf(k1, xw[m + 1], __builtin_fmaf(k2, xw[m + 2], __builtin_fmaf(k3, xw[m + 3], bb))))) * sc[m];
            const float v1 = siluf_(__builtin_fmaf(k0, xw[m + 1], __builtin_fmaf(k1, xw[m + 2], __builtin_fmaf(k2, xw[m + 3], __builtin_fmaf(k3, xw[m + 4], bb))))) * sc[m + 1];
            o[m >> 1] = pk2(v0, v1); }
        *(LAS v4u*)(dst + ((cg * 8 + j) * XTS + tr * 8) * 2) = (v4u){o[0], o[1], o[2], o[3]};
    }
}
__device__ __forceinline__ int ssd_bc_ch(const Frame& F, int g) { return 512 + (F.tid >> 7) * 128 + g * 64 + (F.tid & 7) * 8; }
__device__ __forceinline__ void ssd_stage_bc(Frame& F, const v4u (&raw)[11], int g, const float* cw, const float* cb) {
    if (F.tid >= 256) return;
    const int which = F.tid >> 7, cg = F.tid & 7, tr = (F.tid >> 3) & 15;
    const int ch768 = ssd_bc_ch(F, g);
    LAS unsigned char* dst = F.lds + (which ? SSD_C : SSD_B);
    unsigned o[8][4];
#pragma unroll
    for (int j = 0; j < 8; j += 2) {
        const float k0 = cw[ch768 + j], k1 = cw[768 + ch768 + j], k2 = cw[2 * 768 + ch768 + j], k3 = cw[3 * 768 + ch768 + j], bb = cb[ch768 + j];
        const float q0 = cw[ch768 + j + 1], q1 = cw[768 + ch768 + j + 1], q2 = cw[2 * 768 + ch768 + j + 1], q3 = cw[3 * 768 + ch768 + j + 1], qb = cb[ch768 + j + 1];
        float xw[11], yw[11];
#pragma unroll
        for (int i = 0; i < 11; ++i) { xw[i] = bf_of(raw[i], j); yw[i] = bf_of(raw[i], j + 1); }
#pragma unroll
        for (int m = 0; m < 8; ++m) {
            const float v0 = siluf_(__builtin_fmaf(k0, xw[m], __builtin_fmaf(k1, xw[m + 1], __builtin_fmaf(k2, xw[m + 2], __builtin_fmaf(k3, xw[m + 3], bb)))));
            const float v1 = siluf_(__builtin_fmaf(q0, yw[m], __builtin_fmaf(q1, yw[m + 1], __builtin_fmaf(q2, yw[m + 2], __builtin_fmaf(q3, yw[m + 3], qb)))));
            o[m][j >> 1] = pk2(v0, v1); }
    }
#pragma unroll
    for (int m = 0; m < 8; ++m) *(LAS v4u*)(dst + ((tr * 8 + m) * BCS + cg * 8) * 2) = (v4u){o[m][0], o[m][1], o[m][2], o[m][3]};
}
__device__ __forceinline__ void ssd_passA_unit(Frame& F, int unit, const bf16* U, const float* FD, float* SST, float* CD, const float* cw, const float* cb, const float* dtbias, const float* Alog) {
    relaunder(F);
    const int b = unit >> 5, c = unit & 31;
    v4u rawx[11], rawb[11];
    ssd_load_raw(rawx, b, c, ssd_T_tr<true>(F), ssd_T_ch<true>(F, 0), U);
    if (ssd_T_active<false>(F)) ssd_load_raw(rawb, b, c, ssd_T_tr<false>(F), ssd_T_ch<false>(F, 0), U);
    ssd_scalars(F, b, c, FD, dtbias, Alog);
    if (F.tid < 8) CD[(b * 32 + c) * 8 + F.tid] = __expf(((LAS float*)(F.lds + SSD_AC))[127 * 8 + F.tid]);
#pragma unroll
    for (int g = 0; g < 2; ++g) {
        if (g) __syncthreads();
        ssd_stage_T<true>(F, rawx, g, cw, cb, true);
        ssd_stage_T<false>(F, rawb, g, cw, cb, true);
        __syncthreads();
        if (g == 0) { ssd_load_raw(rawx, b, c, ssd_T_tr<true>(F), ssd_T_ch<true>(F, 1), U); if (ssd_T_active<false>(F)) ssd_load_raw(rawb, b, c, ssd_T_tr<false>(F), ssd_T_ch<false>(F, 1), U); }
        const int hh = F.wave >> 1, pb = F.wave & 1, h = g * 4 + hh, r = F.lane & 31, hi = F.lane >> 5;
        const LAS unsigned char* ap = F.lds + SSD_XT + ((hh * 64 + pb * 32 + r) * XTS + hi * 8) * 2;
#pragma unroll
        for (int nb = 0; nb < 2; ++nb) {
            const LAS unsigned char* bp = F.lds + SSD_B + ((nb * 32 + r) * XTS + hi * 8) * 2;
            f32x16 acc = {0.f, 0.f, 0.f, 0.f, 0.f, 0.f, 0.f, 0.f, 0.f, 0.f, 0.f, 0.f, 0.f, 0.f, 0.f, 0.f};
#pragma unroll
            for (int ks = 0; ks < 8; ++ks) acc = MFMA32(*(const LAS bf16x8*)(ap + ks * 32), *(const LAS bf16x8*)(bp + ks * 32), acc);
            bf16* sp = (bf16*)SST + ((size_t)((b * 32 + c) * 8 + h) * 64) * 64 + nb * 32 + r;
#pragma unroll
            for (int reg = 0; reg < 16; ++reg) sp[(size_t)(pb * 32 + crow16(reg, hi)) * 64] = (bf16)f2bf(acc[reg]);
        }
    }
    __syncthreads();
}
__device__ __forceinline__ void ssd_scan_phase(Frame& F, const float* SST, const float* CD, bf16* HPB, unsigned* done) {
    for (int e = F.vcu * 512 + F.tid; e < NB * 8 * 2048; e += F.G * 512) {
        const int b = e >> 14, rem = (e & 16383) * 2, h = rem >> 12; f32x2 run = {0.f, 0.f};
        unsigned sw[32]; float d[32];
#pragma unroll
        for (int c = 0; c < 32; ++c) { const size_t idx = (size_t)((b * 32 + c) * 8) * 4096 + rem; d[c] = CD[(b * 32 + c) * 8 + h]; sw[c] = *(const unsigned*)((const bf16*)SST + idx); }
#pragma unroll
        for (int c = 0; c < 32; ++c) { const size_t idx = (size_t)((b * 32 + c) * 8) * 4096 + rem; __hip_atomic_store((unsigned*)(HPB + idx), pk2(run.x, run.y), RLX_AGENT);
            const f32x2 sv = {bflo(sw[c]), bfhi(sw[c])}; run = run * d[c] + sv; }
    }
    VM_WAIT(); __syncthreads();
    if (F.tid == 0) __hip_atomic_fetch_add(done, 1u, RLX_AGENT);
}
__device__ __forceinline__ void ssd_scan_wait(Frame& F, unsigned* done) {
    if (F.tid == 0) { unsigned sp = 0;
        while (__hip_atomic_load(done, RLX_AGENT) < (unsigned)F.G) { __builtin_amdgcn_s_sleep(2); if (++sp > (1u << 22)) { __hip_atomic_store((unsigned*)(F.ctl + CW_TMO), 0x5C00u, RLX_AGENT); break; } }
        __builtin_amdgcn_fence(__ATOMIC_ACQUIRE, "agent"); asm volatile("s_waitcnt vmcnt(0)" ::: "memory"); }
    __syncthreads();
}
__device__ __forceinline__ float ssq_f(unsigned long long t) { return (float)(unsigned)(t >> 32) + (float)(unsigned)t * 2.3283064365386963e-10f; }
__device__ __forceinline__ void ssd_passB_unit(Frame& F, int unit, const bf16* U, const float* FD, const bf16* HPB, bf16* Y, const float* cw, const float* cb, const float* dtbias, const float* Alog, const float* Dsk, const float* ng) {
    relaunder(F);
    const int b = unit >> 5, c = unit & 31;
    v4u rawx[11], rawbc[11];
    v2u held[2][4][2];
    LAS unsigned long long* ssq = (LAS unsigned long long*)(F.lds + TBL_OFF);
    if (F.tid < 128) ssq[F.tid] = 0ull;
    ssd_load_raw(rawx, b, c, ssd_T_tr<true>(F), ssd_T_ch<true>(F, 0), U);
    ssd_scalars(F, b, c, FD, dtbias, Alog);
    if (F.tid < 256) ssd_load_raw(rawbc, b, c, (F.tid >> 3) & 15, ssd_bc_ch(F, 0), U);
    LAS float* dts = (LAS float*)(F.lds + SSD_DT); LAS float* acs = (LAS float*)(F.lds + SSD_AC); LAS float* acT = (LAS float*)(F.lds + SSD_ACT);
#pragma unroll
    for (int g = 0; g < 2; ++g) {
        const int hh = F.wave >> 1, th = F.wave & 1, h = g * 4 + hh, r = F.lane & 31, hi = F.lane >> 5;
        const bf16* hp = HPB + (size_t)((b * 32 + c) * 8 + h) * 4096 + r * 64 + hi * 8;
        bf16x8 hq[2][4];
#pragma unroll
        for (int ks = 0; ks < 4; ++ks) { hq[0][ks] = *(const bf16x8*)(hp + ks * 16); hq[1][ks] = *(const bf16x8*)(hp + 32 * 64 + ks * 16); }
        if (g) { ssd_load_raw(rawx, b, c, ssd_T_tr<true>(F), ssd_T_ch<true>(F, 1), U); if (F.tid < 256) ssd_load_raw(rawbc, b, c, (F.tid >> 3) & 15, ssd_bc_ch(F, 1), U); __syncthreads(); }
        ssd_stage_T<true>(F, rawx, g, cw, cb, false);
        ssd_stage_bc(F, rawbc, g, cw, cb);
        __syncthreads();
        const float Dh = Dsk[h];
        const LAS unsigned char* xp = F.lds + SSD_XT + ((hh * 64 + r) * XTS + 4 * hi) * 2;
#pragma unroll
        for (int tq = 0; tq < 2; ++tq) {
            const int tbi = tq == 0 ? th : 3 - th, tl = 32 * tbi + r;
            v2u zq[4][2];
            { const size_t zrow = (size_t)b * SEQ + c * 128 + tl;
#pragma unroll
                for (int g4 = 0; g4 < 4; ++g4) { const int ch = h * 64 + 8 * g4 + 4 * hi; zq[g4][0] = *(const v2u*)(U + zrow * UP + UC_Z + ch); zq[g4][1] = *(const v2u*)(U + zrow * UP + UC_Z + ch + 32); } }
            const float at = acs[tl * 8 + h], dtt = dts[tl * 8 + h], et = __expf(at);
            bf16x8 cf[4];
#pragma unroll
            for (int ks = 0; ks < 4; ++ks) cf[ks] = *(const LAS bf16x8*)(F.lds + SSD_C + (tl * BCS + ks * 16 + hi * 8) * 2);
            f32x16 y0 = {0.f, 0.f, 0.f, 0.f, 0.f, 0.f, 0.f, 0.f, 0.f, 0.f, 0.f, 0.f, 0.f, 0.f, 0.f, 0.f}, y1 = y0;
#pragma unroll
            for (int ks = 0; ks < 4; ++ks) { y0 = MFMA32(hq[0][ks], cf[ks], y0); y1 = MFMA32(hq[1][ks], cf[ks], y1); }
#pragma unroll
            for (int reg = 0; reg < 16; ++reg) { y0[reg] *= et; y1[reg] *= et; }
#pragma unroll 1
            for (int sb = 0; sb <= tbi; ++sb) {
                f32x16 gt = {0.f, 0.f, 0.f, 0.f, 0.f, 0.f, 0.f, 0.f, 0.f, 0.f, 0.f, 0.f, 0.f, 0.f, 0.f, 0.f};
#pragma unroll
                for (int ks = 0; ks < 4; ++ks) gt = MFMA32(*(const LAS bf16x8*)(F.lds + SSD_B + ((32 * sb + r) * BCS + ks * 16 + hi * 8) * 2), cf[ks], gt);
                const bool diag = (sb == tbi);
#pragma unroll
                for (int g4 = 0; g4 < 4; ++g4) { const f32x4 as = *(const LAS f32x4*)(acT + h * 128 + 32 * sb + 8 * g4 + 4 * hi);
#pragma unroll
                    for (int j = 0; j < 4; ++j) { const int sl = 8 * g4 + 4 * hi + j; float v = gt[4 * g4 + j] * __expf(fminf(at - as[j], 0.f));
                        if (diag) { if (sl > r) v = 0.f; if (sl == r) v += Dh * __builtin_amdgcn_rcpf(dtt); }
                        gt[4 * g4 + j] = v; } }
#pragma unroll
                for (int ks2 = 0; ks2 < 2; ++ks2) {
                    const v4u xw = (v4u){pk2(gt[8 * ks2], gt[8 * ks2 + 1]), pk2(gt[8 * ks2 + 2], gt[8 * ks2 + 3]), pk2(gt[8 * ks2 + 4], gt[8 * ks2 + 5]), pk2(gt[8 * ks2 + 6], gt[8 * ks2 + 7])};
                    const bf16x8 xs = __builtin_bit_cast(bf16x8, xw);
                    const LAS unsigned char* xq = xp + (32 * sb + 16 * ks2) * 2;
                    const v2u l0 = *(const LAS v2u*)(xq), h0 = *(const LAS v2u*)(xq + 16), l1 = *(const LAS v2u*)(xq + 32 * XTS * 2), h1 = *(const LAS v2u*)(xq + 32 * XTS * 2 + 16);
                    y0 = MFMA32(__builtin_bit_cast(bf16x8, ((v4u){l0.x, l0.y, h0.x, h0.y})), xs, y0);
                    y1 = MFMA32(__builtin_bit_cast(bf16x8, ((v4u){l1.x, l1.y, h1.x, h1.y})), xs, y1);
                }
            }
            const size_t row = (size_t)b * SEQ + c * 128 + tl; float sq = 0.f;
#pragma unroll
            for (int g4 = 0; g4 < 4; ++g4) { const int ch = h * 64 + 8 * g4 + 4 * hi;
                const v2u z0 = zq[g4][0], z1 = zq[g4][1];
                const float a0 = y0[4 * g4] * siluf_(bflo(z0.x)), a1 = y0[4 * g4 + 1] * siluf_(bfhi(z0.x)), a2 = y0[4 * g4 + 2] * siluf_(bflo(z0.y)), a3 = y0[4 * g4 + 3] * siluf_(bfhi(z0.y));
                const float c0 = y1[4 * g4] * siluf_(bflo(z1.x)), c1 = y1[4 * g4 + 1] * siluf_(bfhi(z1.x)), c2 = y1[4 * g4 + 2] * siluf_(bflo(z1.y)), c3 = y1[4 * g4 + 3] * siluf_(bfhi(z1.y));
                const v2u o0 = (v2u){pk2(a0, a1), pk2(a2, a3)}, o1 = (v2u){pk2(c0, c1), pk2(c2, c3)};
                const float b0 = bflo(o0.x), b1 = bfhi(o0.x), b2 = bflo(o0.y), b3 = bfhi(o0.y), d0 = bflo(o1.x), d1 = bfhi(o1.x), d2 = bflo(o1.y), d3 = bfhi(o1.y);
                sq += (b0 * b0 + b1 * b1) + (b2 * b2 + b3 * b3) + (d0 * d0 + d1 * d1) + (d2 * d2 + d3 * d3);
                if (g == 0) { *(v2u*)(Y + row * YP + YC_SSD + ch) = o0; *(v2u*)(Y + row * YP + YC_SSD + ch + 32) = o1; } else { held[tq][g4][0] = o0; held[tq][g4][1] = o1; } }
            { const float sqc = fminf(sq, 8.0e6f); const unsigned qi = (unsigned)sqc, qf = (unsigned)((sqc - (float)qi) * 4294967296.f);
              __hip_atomic_fetch_add(ssq + tl, ((unsigned long long)qi << 32) | qf, __ATOMIC_RELAXED, __HIP_MEMORY_SCOPE_WORKGROUP); }
        }
    }
    VM_WAIT(); __syncthreads();
    { const int hh = F.wave >> 1, th = F.wave & 1, r = F.lane & 31, hi = F.lane >> 5;
        const f32x4 ga = *(const f32x4*)(ng + F.lane * 4);
        unsigned long long q0[16];
#pragma unroll
        for (int i = 0; i < 16; ++i) { unsigned long long* p = (unsigned long long*)(Y + ((size_t)b * SEQ + c * 128 + F.wave * 16 + i) * YP + YC_SSD) + F.lane; q0[i] = __hip_atomic_load(p, RLX_AGENT); }
#pragma unroll
        for (int tq = 0; tq < 2; ++tq) { const int tbi = tq == 0 ? th : 3 - th, tl = 32 * tbi + r; const float rstd = __builtin_amdgcn_rsqf(ssq_f(ssq[tl]) * (1.f / 512) + EPS);
            const size_t row = (size_t)b * SEQ + c * 128 + tl;
#pragma unroll
            for (int g4 = 0; g4 < 4; ++g4) { const int ch = (4 + hh) * 64 + 8 * g4 + 4 * hi;
#pragma unroll
                for (int pb = 0; pb < 2; ++pb) { const f32x4 gg = *(const f32x4*)(ng + ch + 32 * pb); const v2u hv = held[tq][g4][pb];
                    *(v2u*)(Y + row * YP + YC_SSD + ch + 32 * pb) = (v2u){pk2(bflo(hv.x) * rstd * gg.x, bfhi(hv.x) * rstd * gg.y), pk2(bflo(hv.y) * rstd * gg.z, bfhi(hv.y) * rstd * gg.w)}; } } }
#pragma unroll
        for (int i = 0; i < 16; ++i) { const int tl = F.wave * 16 + i; unsigned long long* p = (unsigned long long*)(Y + ((size_t)b * SEQ + c * 128 + tl) * YP + YC_SSD) + F.lane;
            const float rstd = __builtin_amdgcn_rsqf(ssq_f(ssq[tl]) * (1.f / 512) + EPS);
            const float a0 = bflo((unsigned)q0[i]), a1 = bfhi((unsigned)q0[i]), a2 = bflo((unsigned)(q0[i] >> 32)), a3 = bfhi((unsigned)(q0[i] >> 32));
            p[0] = (unsigned long long)pk2(a0 * rstd * ga.x, a1 * rstd * ga.y) | ((unsigned long long)pk2(a2 * rstd * ga.z, a3 * rstd * ga.w) << 32); } }
    __syncthreads();
}

__device__ __forceinline__ void ssd_norm_phase(Frame& F, bf16* Y, const float* ng) {
    const int gw = F.vcu * 8 + F.wave, NGW = F.G * 8, ch0 = F.lane * 8;
    const f32x4 ga = *(const f32x4*)(ng + ch0), gb = *(const f32x4*)(ng + ch0 + 4);
    for (int m = gw; m < M; m += NGW) { bf16* p = Y + (size_t)m * YP + YC_SSD + ch0; const v4u v = *(const v4u*)p;
        const float a0 = bflo(v.x), a1 = bfhi(v.x), a2 = bflo(v.y), a3 = bfhi(v.y), a4 = bflo(v.z), a5 = bfhi(v.z), a6 = bflo(v.w), a7 = bfhi(v.w);
        const float ss = wave_sum((a0 * a0 + a1 * a1) + (a2 * a2 + a3 * a3) + (a4 * a4 + a5 * a5) + (a6 * a6 + a7 * a7));
        const float rstd = __builtin_amdgcn_rsqf(ss * (1.f / 512) + EPS);
        v4u o; o.x = pk2(a0 * rstd * ga.x, a1 * rstd * ga.y); o.y = pk2(a2 * rstd * ga.z, a3 * rstd * ga.w); o.z = pk2(a4 * rstd * gb.x, a5 * rstd * gb.y); o.w = pk2(a6 * rstd * gb.z, a7 * rstd * gb.w);
        *(v4u*)p = o; }
}

__device__ __forceinline__ void attn_naive_phase(Frame& F, const bf16* U, const float* FC, bf16* Y) {
    LAS float* Ks = (LAS float*)(F.lds); LAS float* Vs = Ks + 4096; LAS float* Cs = Vs + 4096;
    const int hf = F.tid & 1;
    for (int i = 0; ; ++i) {
        const int L = i * F.G + F.vcu; if (L >= 1024) break;
        relaunder(F);
        const int bh = (L & 255) >> 2, s = L & 3, jj = L >> 8, qb = jj == 0 ? s : (jj == 1 ? 7 - s : (jj == 2 ? 8 + s : 15 - s));
        const int b = bh >> 3, h = bh & 7, q = qb * 256 + (F.tid >> 1);
        float qv[32], o[32];
        { const v4u* qp = (const v4u*)(U + ((size_t)b * SEQ + q) * UP + UC_Q + h * 64 + hf * 32);
#pragma unroll
            for (int j = 0; j < 4; ++j) { const v4u w = qp[j]; qv[8 * j + 0] = bflo(w.x); qv[8 * j + 1] = bfhi(w.x); qv[8 * j + 2] = bflo(w.y); qv[8 * j + 3] = bfhi(w.y); qv[8 * j + 4] = bflo(w.z); qv[8 * j + 5] = bfhi(w.z); qv[8 * j + 6] = bflo(w.w); qv[8 * j + 7] = bfhi(w.w); } }
#pragma unroll
        for (int d = 0; d < 32; ++d) o[d] = 0.f;
        const float cq = FC[(size_t)bh * SEQ + q];
        float mrun = -1e30f, lrun = 0.f;
        const int nkt = (qb * 256 + 256) / 64;
#pragma unroll 1
        for (int kt = 0; kt < nkt; ++kt) {
            __syncthreads();
            { const int key = F.tid >> 3, d0 = (F.tid & 7) * 8; const size_t row = (size_t)b * SEQ + kt * 64 + key;
                const v4u kw = *(const v4u*)(U + row * UP + UC_K + h * 64 + d0), vw = *(const v4u*)(U + row * UP + UC_V + h * 64 + d0);
                LAS float* kd = Ks + key * 64 + d0; LAS float* vd = Vs + key * 64 + d0;
                *(LAS f32x4*)kd = (f32x4){bflo(kw.x), bfhi(kw.x), bflo(kw.y), bfhi(kw.y)}; *(LAS f32x4*)(kd + 4) = (f32x4){bflo(kw.z), bfhi(kw.z), bflo(kw.w), bfhi(kw.w)};
                *(LAS f32x4*)vd = (f32x4){bflo(vw.x), bfhi(vw.x), bflo(vw.y), bfhi(vw.y)}; *(LAS f32x4*)(vd + 4) = (f32x4){bflo(vw.z), bfhi(vw.z), bflo(vw.w), bfhi(vw.w)};
                if (F.tid < 64) Cs[F.tid] = FC[(size_t)bh * SEQ + kt * 64 + F.tid]; }
            __syncthreads();
#pragma unroll 1
            for (int jc = 0; jc < 16; ++jc) {
                float sc[4]; float cm = -1e30f;
#pragma unroll
                for (int j = 0; j < 4; ++j) { const int key = jc * 4 + j; float d = 0.f;
#pragma unroll
                    for (int dd = 0; dd < 32; dd += 4) { const f32x4 kk = *(const LAS f32x4*)(Ks + key * 64 + hf * 32 + dd); d += qv[dd] * kk.x + qv[dd + 1] * kk.y + qv[dd + 2] * kk.z + qv[dd + 3] * kk.w; }
                    d += DPP_F(d, 0xB1);
                    d += (cq - Cs[key]) * LOG2E; if (kt * 64 + key > q) d = -1e30f; sc[j] = d; cm = fmaxf(cm, d); }
                asm volatile("" ::: "memory");
                const float mn = fmaxf(mrun, cm), f = __builtin_amdgcn_exp2f(mrun - mn); lrun *= f; mrun = mn;
#pragma unroll
                for (int d = 0; d < 32; ++d) o[d] *= f;
#pragma unroll
                for (int j = 0; j < 4; ++j) { const int key = jc * 4 + j; const float pj = __builtin_amdgcn_exp2f(sc[j] - mrun); lrun += pj;
#pragma unroll
                    for (int dd = 0; dd < 32; dd += 4) { const f32x4 vv = *(const LAS f32x4*)(Vs + key * 64 + hf * 32 + dd); o[dd] += pj * vv.x; o[dd + 1] += pj * vv.y; o[dd + 2] += pj * vv.z; o[dd + 3] += pj * vv.w; } }
                asm volatile("" ::: "memory");
            }
        }
        const float rl = 1.0f / lrun;
        v4u* op = (v4u*)(Y + ((size_t)b * SEQ + q) * YP + YC_ATT + h * 64 + hf * 32);
#pragma unroll
        for (int j = 0; j < 4; ++j) { v4u w; w.x = pk2(o[8 * j] * rl, o[8 * j + 1] * rl); w.y = pk2(o[8 * j + 2] * rl, o[8 * j + 3] * rl); w.z = pk2(o[8 * j + 4] * rl, o[8 * j + 5] * rl); w.w = pk2(o[8 * j + 6] * rl, o[8 * j + 7] * rl); op[j] = w; }
    }
    __syncthreads();
}

namespace attn_body {
using bf16=__hip_bfloat16;
using bf16x8=__attribute__((ext_vector_type(8)))short;
using s16x4=__attribute__((ext_vector_type(4)))short;
using f32x16=__attribute__((ext_vector_type(16)))float;
using u32x4=__attribute__((ext_vector_type(4)))unsigned;
constexpr int BATCH=8,NHEAD=8,SEQ=4096,D=64,DM=3328,OPITCH=1536;
constexpr int NW=8,QBLK=32,QB=QBLK*NW,KVBLK=64,NQB=SEQ/QB;
constexpr int ATTN_PITCH=DM, ATTN_UNIT_ROWS=QB;
constexpr int LDS_BIAS=86016;
__device__ __forceinline__ int crow(int r,int hi){return (r&3)+8*(r>>2)+4*hi;}
#define SBAR() __builtin_amdgcn_sched_barrier(0)
__device__ __forceinline__ void cmask(f32x16&p0,f32x16&p1,int jb,int qrel,int hi){
  const float NEG=-INFINITY; int kb=64*jb+4*hi;
  #pragma unroll
  for(int r=0;r<16;++r){int kv=kb+(r&3)+8*(r>>2); if(kv>qrel)p0[r]=NEG; if(kv+32>qrel)p1[r]=NEG;}
}

constexpr int NSLOT=3, SLOTB=8192;
constexpr int LDS_K=0, LDS_V=NSLOT*SLOTB, LDS_WS=2*NSLOT*SLOTB, LDS_OST=LDS_WS+NW*64*4, LDS_BYTES=LDS_OST+NW*4096;
constexpr float C2A=0.125f*1.4426950408889634f;
__device__ __forceinline__ void glds16(const void*gsrc,unsigned lds_dst){unsigned keep;
  asm volatile("s_mov_b32 %0, m0\n\ts_mov_b32 m0, %2\n\ts_nop 0\n\tglobal_load_lds_dwordx4 %1, off\n\ts_mov_b32 m0, %0":"=&s"(keep):"v"(gsrc),"s"(lds_dst):"memory");}
__device__ __forceinline__ float max3f(float a,float b,float c){float r;asm("v_max3_f32 %0, %1, %2, %3":"=v"(r):"v"(a),"v"(b),"v"(c));return r;}
__device__ __forceinline__ float max2f(float a,float b){float r;asm("v_max_f32_e32 %0, %1, %2":"=v"(r):"v"(a),"v"(b));return r;}
__device__ __forceinline__ float fadd_s(float a,float b){float r;asm("v_add_f32_e32 %0, %1, %2":"=v"(r):"v"(a),"v"(b));return r;}
__device__ __forceinline__ float fsub_s(float a,float b){float r;asm("v_sub_f32_e32 %0, %1, %2":"=v"(r):"v"(a),"v"(b));return r;}
typedef float f32x2_t __attribute__((ext_vector_type(2))); typedef __bf16 bf16x2_t __attribute__((ext_vector_type(2)));
__device__ __forceinline__ unsigned cvtpk_s(float lo,float hi){f32x2_t v={lo,hi};bf16x2_t b=__builtin_convertvector(v,bf16x2_t);return __builtin_bit_cast(unsigned,b);}
#define WAIT_BAR(N) asm volatile("s_waitcnt vmcnt(" #N ") lgkmcnt(0)\n\ts_barrier":::"memory")

__device__ __forceinline__ void qkt(f32x16&p0,f32x16&p1,const char*Kslot,const bf16x8*qr,int r32,int hi){ const f32x16 zc=f32x16{};
  const char*kb=Kslot+hi*1024+r32*16;
  #pragma unroll
  for(int d0=0;d0<4;++d0){
    const bf16x8 b0=*reinterpret_cast<const bf16x8*>(kb+d0*2048);
    const bf16x8 b1=*reinterpret_cast<const bf16x8*>(kb+d0*2048+512);
    if(d0==0){p0=__builtin_amdgcn_mfma_f32_32x32x16_bf16(b0,qr[0],zc,0,0,0);p1=__builtin_amdgcn_mfma_f32_32x32x16_bf16(b1,qr[0],zc,0,0,0);}
    else{p0=__builtin_amdgcn_mfma_f32_32x32x16_bf16(b0,qr[d0],p0,0,0,0);p1=__builtin_amdgcn_mfma_f32_32x32x16_bf16(b1,qr[d0],p1,0,0,0);}}
}
typedef __attribute__((address_space(3))) const char* lds_cptr;
typedef short v4i16_t __attribute__((ext_vector_type(4)));
__device__ __forceinline__ void kload8(bf16x8*kf,lds_cptr kp){
  kf[0]=*(const __attribute__((address_space(3))) bf16x8*)(kp);      kf[1]=*(const __attribute__((address_space(3))) bf16x8*)(kp+512);
  kf[2]=*(const __attribute__((address_space(3))) bf16x8*)(kp+2048); kf[3]=*(const __attribute__((address_space(3))) bf16x8*)(kp+2560);
  kf[4]=*(const __attribute__((address_space(3))) bf16x8*)(kp+4096); kf[5]=*(const __attribute__((address_space(3))) bf16x8*)(kp+4608);
  kf[6]=*(const __attribute__((address_space(3))) bf16x8*)(kp+6144); kf[7]=*(const __attribute__((address_space(3))) bf16x8*)(kp+6656);
}
__device__ __forceinline__ void kload2(bf16x8*kf,lds_cptr kp,int j){ kf[2*j]=*(const __attribute__((address_space(3))) bf16x8*)(kp+j*2048); kf[2*j+1]=*(const __attribute__((address_space(3))) bf16x8*)(kp+j*2048+512); }
__device__ __forceinline__ s16x4 vtr(lds_cptr p){ return __builtin_bit_cast(s16x4,__builtin_amdgcn_ds_read_tr16_b64_v4i16((__attribute__((address_space(3))) v4i16_t*)p)); }
__device__ __forceinline__ float rowmax(const f32x16&p0,const f32x16&p1){
  float a=max3f(p0[0],p0[1],p1[0]),b=max3f(p0[2],p0[3],p1[1]);a=max3f(a,p1[2],p1[3]);
  #pragma unroll
  for(int r=4;r<16;r+=4){a=max3f(a,p0[r],p0[r+1]);b=max3f(b,p0[r+2],p0[r+3]);a=max3f(a,p1[r],p1[r+1]);b=max3f(b,p1[r+2],p1[r+3]);}
  const float m=max2f(a,b);
  auto rr=__builtin_amdgcn_permlane32_swap(__float_as_uint(m),__float_as_uint(m),false,false);
  return max2f(__uint_as_float(rr[0]),__uint_as_float(rr[1]));
}
__device__ __forceinline__ void pv(f32x16*o,int vb,bf16x8 pa0,bf16x8 pa1,bf16x8 pa2,bf16x8 pa3){
  #pragma unroll
  for(int d0=0;d0<2;++d0){s16x4 lo[4],hi[4];
    #pragma unroll
    for(int ks=0;ks<4;++ks){
      asm volatile("ds_read_b64_tr_b16 %0,%1 offset:%c2":"=&v"(lo[ks]):"v"(vb),"i"(d0*4096+ks*1024):"memory");
      asm volatile("ds_read_b64_tr_b16 %0,%1 offset:%c2":"=&v"(hi[ks]):"v"(vb),"i"(d0*4096+ks*1024+512):"memory");}
    asm volatile("s_waitcnt lgkmcnt(0)":::"memory");SBAR();
    #define PK(k) (bf16x8){lo[k][0],lo[k][1],lo[k][2],lo[k][3],hi[k][0],hi[k][1],hi[k][2],hi[k][3]}
    o[d0]=__builtin_amdgcn_mfma_f32_32x32x16_bf16(pa0,PK(0),o[d0],0,0,0);
    o[d0]=__builtin_amdgcn_mfma_f32_32x32x16_bf16(pa1,PK(1),o[d0],0,0,0);
    o[d0]=__builtin_amdgcn_mfma_f32_32x32x16_bf16(pa2,PK(2),o[d0],0,0,0);
    o[d0]=__builtin_amdgcn_mfma_f32_32x32x16_bf16(pa3,PK(3),o[d0],0,0,0);
    #undef PK
  }
}

#ifndef ATTN_STORE16
#define ATTN_STORE16(p,v) (*(u32x4*)(p)=(v))
#endif
template<int THRL> __device__ __forceinline__ void attn_unit(int tid_in,int b,int h,int qb,int t0,const bf16*Q,const bf16*__restrict__ K,const bf16*__restrict__ V,bf16*O,const float*__restrict__ FCb,char*shm){
  int tid_=tid_in; asm volatile("":"+v"(tid_));
  const int tid=tid_,lane=tid&63,r32=lane&31,hi=lane>>5; const int wid=__builtin_amdgcn_readfirstlane(tid>>6);
  const long rowbase=(long)b*SEQ; const int q0=qb*QB;
  const bf16*Qw=Q+(rowbase+q0+wid*QBLK)*DM+h*D;
  const bf16*Kh=K+(rowbase+(long)t0*KVBLK)*DM+h*D,*Vh=V+(rowbase+(long)t0*KVBLK)*DM+h*D;
  const unsigned lds0=(unsigned)(uintptr_t)shm;
  const lds_cptr shm3=(lds_cptr)shm;
  float*wsf=(float*)(shm+LDS_WS)+wid*64;
  const bf16*ksrc=Kh+(long)lane*DM+wid*8;
  const bf16*vsrc=Vh+(long)(16*(wid&3)+(lane>>2))*DM+(wid>>2)*32+(lane&3)*8;
  const unsigned kdst=lds0+LDS_K+wid*1024, vdst=lds0+LDS_V+wid*1024;
  #define DMA_K(t,slot) glds16(ksrc+(long)(t)*KVBLK*DM,(unsigned)__builtin_amdgcn_readfirstlane(kdst+(slot)))
  #define DMA_V(t,slot) glds16(vsrc+(long)(t)*KVBLK*DM,(unsigned)__builtin_amdgcn_readfirstlane(vdst+(slot)))
  const int vb0=(int)(lds0+LDS_V)+((lane>>4)&1)*32+(lane&3)*8+(4*hi+((lane&15)>>2))*64;
  const char*Kbase=shm+LDS_K; bf16x8 kf[8];
  const lds_cptr kp0=shm3+LDS_K+hi*1024+r32*16; const lds_cptr vp0=shm3+LDS_V+((lane>>4)&1)*32+(lane&3)*8+(4*hi+((lane&15)>>2))*64;
  const int NT=(q0+QB)/KVBLK-t0;
  DMA_K(0,0);DMA_V(0,0);DMA_K(1,SLOTB);
  float mrow;
  { typedef float f4_t __attribute__((ext_vector_type(4)));
    const float cref=FCb[q0]; const int nk=q0+QB; mrow=(cref-FCb[q0+wid*QBLK+r32])*1.4426950408889634f;
    __attribute__((address_space(3))) float*bl=(__attribute__((address_space(3))) float*)(shm3+LDS_BIAS);
    for(int k=t0*64+tid*4;k<nk;k+=2048){ const f4_t c=*reinterpret_cast<const f4_t*>(FCb+k); f4_t o; o.x=(cref-c.x)*1.4426950408889634f; o.y=(cref-c.y)*1.4426950408889634f; o.z=(cref-c.z)*1.4426950408889634f; o.w=(cref-c.w)*1.4426950408889634f;
      *reinterpret_cast<__attribute__((address_space(3))) f4_t*>(bl+k)=o; }
    asm volatile("s_waitcnt vmcnt(0) lgkmcnt(0)":::"memory"); }
  bf16x8 qr[4];
  #pragma unroll
  for(int d0=0;d0<4;++d0)qr[d0]=*reinterpret_cast<const bf16x8*>(&Qw[(long)r32*DM+d0*16+hi*8]);
  float mhat=FOX_FIXED_REF?mrow:0.f,l_reg=0.f;f32x16 o[2];o[0]=f32x16{};o[1]=f32x16{};const f32x16 zc=f32x16{};
  const int qrel=wid*QBLK+r32;
  #define CMASK(P0,P1,t) do{int jb_=(t)-(NT-4); if(jb_>=0)cmask(P0,P1,jb_,qrel,hi);}while(0)
  typedef float f4b_t __attribute__((ext_vector_type(4)));
  const __attribute__((address_space(3))) float* blp=(const __attribute__((address_space(3))) float*)(shm3+LDS_BIAS)+4*hi+t0*64;
  #define BIAS(P0,P1,t) do{ const __attribute__((address_space(3))) float* bp_=blp+(t)*64; const float nm_=-mhat; \
    _Pragma("unroll") for(int g_=0;g_<4;++g_){ const f4b_t b0_=*reinterpret_cast<const __attribute__((address_space(3))) f4b_t*>(bp_+8*g_); const f4b_t b1_=*reinterpret_cast<const __attribute__((address_space(3))) f4b_t*>(bp_+32+8*g_); \
      P0[4*g_]+=b0_.x+nm_;P0[4*g_+1]+=b0_.y+nm_;P0[4*g_+2]+=b0_.z+nm_;P0[4*g_+3]+=b0_.w+nm_; P1[4*g_]+=b1_.x+nm_;P1[4*g_+1]+=b1_.y+nm_;P1[4*g_+2]+=b1_.z+nm_;P1[4*g_+3]+=b1_.w+nm_; } }while(0)
  #define BLOAD(P0,P1,tt) do{ const __attribute__((address_space(3))) float* bp_=blp+(tt)*64; \
    _Pragma("unroll") for(int g_=0;g_<4;++g_){ const f4b_t b0_=*reinterpret_cast<const __attribute__((address_space(3))) f4b_t*>(bp_+8*g_); const f4b_t b1_=*reinterpret_cast<const __attribute__((address_space(3))) f4b_t*>(bp_+32+8*g_); \
      P0[4*g_]=b0_.x;P0[4*g_+1]=b0_.y;P0[4*g_+2]=b0_.z;P0[4*g_+3]=b0_.w; P1[4*g_]=b1_.x;P1[4*g_+1]=b1_.y;P1[4*g_+2]=b1_.z;P1[4*g_+3]=b1_.w; } }while(0)
  #define BSUB(P0,P1) do{ _Pragma("unroll") for(int r=0;r<16;++r){P0[r]-=mhat;P1[r]-=mhat;} }while(0)
  bool resc=false;
#if FOX_FIXED_REF
  #define START(P0,P1) do{ _Pragma("unroll") for(int r=0;r<16;++r)P0[r]=__builtin_amdgcn_exp2f(P0[r]); }while(0)
  #define REFTRACK(C0,C1) do{}while(0)
#else
  #define START(P0,P1) do{ const float rm=rowmax(P0,P1); resc=false; \
    { const float dl=rm; mhat=fadd_s(mhat,dl); \
      _Pragma("unroll") for(int r=0;r<16;++r){P0[r]=fsub_s(P0[r],dl);P1[r]=fsub_s(P1[r],dl);} \
      } \
    _Pragma("unroll") for(int r=0;r<16;++r)P0[r]=__builtin_amdgcn_exp2f(P0[r]); }while(0)
  #define REFTRACK(C0,C1) do{ float a=MX3(C0[0],C0[1],C1[0]),b=MX3(C0[2],C0[3],C1[1]); a=MX3(a,C1[2],C1[3]); \
      _Pragma("unroll") for(int r=4;r<16;r+=4){a=MX3(a,C0[r],C0[r+1]);b=MX3(b,C0[r+2],C0[r+3]);a=MX3(a,C1[r],C1[r+1]);b=MX3(b,C1[r+2],C1[r+3]);} \
      float rm=__builtin_fmaxf(a,b); { auto rr=__builtin_amdgcn_permlane32_swap(__float_as_uint(rm),__float_as_uint(rm),false,false); rm=__builtin_fmaxf(__uint_as_float(rr[0]),__uint_as_float(rr[1])); } \
      resc=false; \
      if(__builtin_expect(__any(rm>(float)THRL),0)){ const float dl=__builtin_fmaxf(rm,0.f); mhat+=dl; \
        _Pragma("unroll") for(int r=0;r<16;++r){C0[r]-=dl;C1[r]-=dl;} \
        const float f=__builtin_amdgcn_exp2f(-dl); l_reg*=f; if(hi==0)wsf[r32]=f; resc=true; } }while(0)
#endif
#if FOX_FIXED_REF
  #define RESC() do{}while(0)
#else
  #define RESC() do{ if(resc){ asm volatile("s_waitcnt lgkmcnt(0)":::"memory"); \
      _Pragma("unroll") for(int d_=0;d_<2;++d_) _Pragma("unroll") for(int r=0;r<16;++r)o[d_][r]*=wsf[crow(r,hi)]; } }while(0)
#endif
  f32x16 pA0,pA1,pB0,pB1;
  int sl_prev=0,sl_cur=0,sl_next=SLOTB;
  #define ROT() do{sl_prev=sl_cur;sl_cur=sl_next;sl_next=(sl_next==(NSLOT-1)*SLOTB)?0:sl_next+SLOTB;}while(0)
  DMA_K(2,2*SLOTB);
  WAIT_BAR(3);
  qkt(pA0,pA1,Kbase,qr,r32,hi);asm volatile("s_nop 15\n\ts_nop 7":"+v"(pA0),"+v"(pA1));BIAS(pA0,pA1,0);CMASK(pA0,pA1,0);
  START(pA0,pA1);
  _Pragma("unroll") for(int r=0;r<16;++r)pA1[r]=__builtin_amdgcn_exp2f(pA1[r]);
  WAIT_BAR(0);
  DMA_K(3,0);DMA_V(1,SLOTB);
  ROT();
  kload8(kf,kp0+sl_cur);
  WAIT_BAR(2);
  s16x4 vlo[8],vhi[8]; u32x4 pw0,pw1,pw2,pw3;
  #define PKW(P,B) cvtpk_s(P[B],P[B+1])
  #define PAF(k) __builtin_bit_cast(bf16x8,pw##k)
  #define VFR(i) (bf16x8){vlo[i][0],vlo[i][1],vlo[i][2],vlo[i][3],vhi[i][0],vhi[i][1],vhi[i][2],vhi[i][3]}
  #define PIN(x) asm volatile("":"+v"(x))
  #define MX3(a,b,c) __builtin_fmaxf(__builtin_fmaxf((a),(b)),(c))
  #define GAPA(MF,A0,A1,A2,A3,W0,W1,PW) do{ MF; sacc+=A0; sacc+=A1; sacc+=A2; sacc+=A3; PIN(sacc); W0; W1; PIN(PW); SBAR(); }while(0)
  #define EX(v) __builtin_amdgcn_exp2f(v)
  #define GAPB(MF,X,B) do{ MF; X[B]=EX(X[B]); X[B+1]=EX(X[B+1]); X[B+2]=EX(X[B+2]); X[B+3]=EX(X[B+3]); PIN(X); SBAR(); }while(0)
  #define VRD(i) do{ vlo[i]=vtr(vp_+(((i)>>2)*4096+((i)&3)*1024)); vhi[i]=vtr(vp_+(((i)>>2)*4096+((i)&3)*1024+512)); }while(0)
  #define KRD(G,j) do{ if(G){ kload2(kf,kp0+sl_next,j); SBAR(); } }while(0)
  #define STEP(C0,C1,P0,P1,t,GK,GV,GL) do{ SBAR(); \
    const lds_cptr vp_=vp0+sl_prev; \
    VRD(0); SBAR(); float sacc=(P0[0]+P0[1]); \
    GAPA(C0=__builtin_amdgcn_mfma_f32_32x32x16_bf16(kf[0],qr[0],C0,0,0,0), P0[2],P0[3],P0[4],P0[5],     pw0[0]=PKW(P0,0), pw0[1]=PKW(P0,2), pw0); \
    VRD(4); SBAR(); GAPA(C1=__builtin_amdgcn_mfma_f32_32x32x16_bf16(kf[1],qr[0],C1,0,0,0), P0[6],P0[7],P0[8],P0[9],     pw0[2]=PKW(P0,4), pw0[3]=PKW(P0,6), pw0); \
    VRD(1); SBAR(); GAPA(C0=__builtin_amdgcn_mfma_f32_32x32x16_bf16(kf[2],qr[1],C0,0,0,0),   P0[10],P0[11],P0[12],P0[13], pw1[0]=PKW(P0,8), pw1[1]=PKW(P0,10), pw1); \
    VRD(5); SBAR(); GAPA(C1=__builtin_amdgcn_mfma_f32_32x32x16_bf16(kf[3],qr[1],C1,0,0,0),   P0[14],P0[15],P1[0],P1[1],   pw1[2]=PKW(P0,12),pw1[3]=PKW(P0,14), pw1); \
    VRD(2); SBAR(); GAPA(C0=__builtin_amdgcn_mfma_f32_32x32x16_bf16(kf[4],qr[2],C0,0,0,0),   P1[2],P1[3],P1[4],P1[5],     pw2[0]=PKW(P1,0), pw2[1]=PKW(P1,2), pw2); \
    VRD(6); SBAR(); GAPA(C1=__builtin_amdgcn_mfma_f32_32x32x16_bf16(kf[5],qr[2],C1,0,0,0),   P1[6],P1[7],P1[8],P1[9],     pw2[2]=PKW(P1,4), pw2[3]=PKW(P1,6), pw2); \
    VRD(3); SBAR(); GAPA(C0=__builtin_amdgcn_mfma_f32_32x32x16_bf16(kf[6],qr[3],C0,0,0,0),   P1[10],P1[11],P1[12],P1[13], pw3[0]=PKW(P1,8), pw3[1]=PKW(P1,10), pw3); \
    VRD(7); SBAR(); GAPA(C1=__builtin_amdgcn_mfma_f32_32x32x16_bf16(kf[7],qr[3],C1,0,0,0),   P1[14],P1[15],0.f,0.f,       pw3[2]=PKW(P1,12),pw3[3]=PKW(P1,14), pw3); \
    l_reg+=sacc; \
    if(GK){DMA_K((t)+3,sl_cur);} if(GV){DMA_V((t)+1,sl_next);} \
    CMASK(C0,C1,t); \
    REFTRACK(C0,C1); \
    SBAR(); \
    BLOAD(P0,P1,(t)+1); \
    GAPB(o[0]=__builtin_amdgcn_mfma_f32_32x32x16_bf16(PAF(0),VFR(0),o[0],0,0,0), C0,0); \
    GAPB(o[1]=__builtin_amdgcn_mfma_f32_32x32x16_bf16(PAF(0),VFR(4),o[1],0,0,0), C0,4); \
    KRD(GL,0); GAPB(o[0]=__builtin_amdgcn_mfma_f32_32x32x16_bf16(PAF(1),VFR(1),o[0],0,0,0), C0,8); \
    KRD(GL,1); GAPB(o[1]=__builtin_amdgcn_mfma_f32_32x32x16_bf16(PAF(1),VFR(5),o[1],0,0,0), C0,12); \
    KRD(GL,2); GAPB(o[0]=__builtin_amdgcn_mfma_f32_32x32x16_bf16(PAF(2),VFR(2),o[0],0,0,0), C1,0); \
    KRD(GL,3); GAPB(o[1]=__builtin_amdgcn_mfma_f32_32x32x16_bf16(PAF(2),VFR(6),o[1],0,0,0), C1,4); \
    GAPB(o[0]=__builtin_amdgcn_mfma_f32_32x32x16_bf16(PAF(3),VFR(3),o[0],0,0,0), C1,8); \
    GAPB(o[1]=__builtin_amdgcn_mfma_f32_32x32x16_bf16(PAF(3),VFR(7),o[1],0,0,0), C1,12); \
    BSUB(P0,P1); \
    }while(0)
  BLOAD(pB0,pB1,1); BSUB(pB0,pB1);
  int t=1;
  #undef CMASK
  #define CMASK(P0,P1,t) do{}while(0)
  for(;t+5<NT;t+=2){
    STEP(pB0,pB1,pA0,pA1,t,true,true,true);     WAIT_BAR(2); RESC(); ROT();
    STEP(pA0,pA1,pB0,pB1,t+1,true,true,true);   WAIT_BAR(2); RESC(); ROT();
  }
  #undef CMASK
  #define CMASK(P0,P1,t) do{int jb_=(t)-(NT-4); if(jb_>=0)cmask(P0,P1,jb_,qrel,hi);}while(0)
  #define ENDW(tt) do{ if((tt)+3<NT){WAIT_BAR(2);} else if((tt)+2<NT){WAIT_BAR(1);} else {WAIT_BAR(0);} }while(0)
  for(;t+1<NT;t+=2){
    STEP(pB0,pB1,pA0,pA1,t,(t+3<NT),(t+1<NT),(t+1<NT));       ENDW(t);   RESC(); ROT();
    STEP(pA0,pA1,pB0,pB1,t+1,(t+4<NT),(t+2<NT),(t+2<NT));     ENDW(t+1); RESC(); ROT();
  }
  STEP(pB0,pB1,pA0,pA1,NT-1,false,false,false); RESC();
  { float sacc=pB0[0]+pB0[1]; _Pragma("unroll") for(int r=2;r<16;++r)sacc+=pB0[r]; _Pragma("unroll") for(int r=0;r<16;++r)sacc+=pB1[r]; l_reg+=sacc;
    pw0=(u32x4){PKW(pB0,0),PKW(pB0,2),PKW(pB0,4),PKW(pB0,6)};pw1=(u32x4){PKW(pB0,8),PKW(pB0,10),PKW(pB0,12),PKW(pB0,14)};pw2=(u32x4){PKW(pB1,0),PKW(pB1,2),PKW(pB1,4),PKW(pB1,6)};pw3=(u32x4){PKW(pB1,8),PKW(pB1,10),PKW(pB1,12),PKW(pB1,14)};
    SBAR(); pv(o,vb0+sl_cur,PAF(0),PAF(1),PAF(2),PAF(3)); }
  #undef PKW
  #undef PAF
  #undef VFR
  #undef PIN
  #undef MX3
  #undef GAPA
  #undef GAPB
  #undef EX
  #undef VRD
  #undef KRD
  #undef STEP
  #undef ENDW
  {auto rr=__builtin_amdgcn_permlane32_swap(__float_as_uint(l_reg),__float_as_uint(l_reg),false,false);l_reg=__uint_as_float(rr[0])+__uint_as_float(rr[1]);}
  if(hi==0)wsf[32+r32]=l_reg;asm volatile("s_waitcnt lgkmcnt(0)":::"memory");
  float rli[16];
  #pragma unroll
  for(int r=0;r<16;++r)rli[r]=__builtin_amdgcn_rcpf(wsf[32+crow(r,hi)]);
  { bf16*stg=(bf16*)(shm+LDS_OST)+wid*2048;
    #pragma unroll
    for(int r=0;r<16;++r){const int orow=crow(r,hi);
      #pragma unroll
      for(int d0=0;d0<2;++d0)stg[orow*64+d0*32+r32]=__float2bfloat16(o[d0][r]*rli[r]);}
    asm volatile("s_waitcnt lgkmcnt(0)":::"memory");
    #pragma unroll
    for(int i=0;i<4;++i){const int row=i*8+(lane>>3),ch=lane&7; const u32x4 v=*(const u32x4*)(stg+row*64+ch*8);
      int o0=0,o1=0; o0=__builtin_amdgcn_cvt_pk_fp8_f32(bflo(v.x)*OUT_Y_SCALE,bfhi(v.x)*OUT_Y_SCALE,o0,false); o0=__builtin_amdgcn_cvt_pk_fp8_f32(bflo(v.y)*OUT_Y_SCALE,bfhi(v.y)*OUT_Y_SCALE,o0,true);
      o1=__builtin_amdgcn_cvt_pk_fp8_f32(bflo(v.z)*OUT_Y_SCALE,bfhi(v.z)*OUT_Y_SCALE,o1,false); o1=__builtin_amdgcn_cvt_pk_fp8_f32(bflo(v.w)*OUT_Y_SCALE,bfhi(v.w)*OUT_Y_SCALE,o1,true);
      *(v2u*)((unsigned char*)O+((rowbase+q0+wid*QBLK+row)*512+h*D+ch*8))=(v2u){(unsigned)o0,(unsigned)o1};} }
  asm volatile("s_waitcnt lgkmcnt(0)\n\ts_barrier":::"memory");
  #undef DMA_K
  #undef DMA_V
  #undef REFTRACK
  #undef CMASK
  #undef BIAS
  #undef BLOAD
  #undef BSUB
  #undef START
  #undef RESC
  #undef ROT
}
constexpr int ATTN_LDS_BYTES=LDS_BYTES;
struct AttnTensors { const bf16* Q; const bf16* K; const bf16* V; bf16* O; const float* FC; const int* TS; unsigned* queue; };
struct AttnUnit { int bh; int qb; };
struct StaticOrder {
  int vcu,G;
  __device__ __forceinline__ StaticOrder(int grid,int v):vcu(v),G(grid){}
  __device__ __forceinline__ bool next(int i,AttnUnit&u)const{ const int L=i*G+vcu; if(L>=BATCH*NHEAD*NQB)return false; const int s=L&3,jj=L>>8; u.bh=(L&255)>>2; u.qb=(jj==0)?s:(jj==1)?7-s:(jj==2)?8+s:15-s; return true; }
  __device__ __forceinline__ void a_ready(const AttnUnit&)const{}
  __device__ __forceinline__ void done(const AttnUnit&)const{}
};
constexpr int LDS_TS=102400, LDS_QW=LDS_TS+4096;
template<class Sched,class Extra,int THRL=8> __device__ __forceinline__ void attn_phase(int tid_in,char*lds,const AttnTensors&T,const Sched&S,const Extra&X){
  __attribute__((address_space(3))) int* tsl=(__attribute__((address_space(3))) int*)((__attribute__((address_space(3))) char*)lds+LDS_TS);
  __syncthreads();
  for(int i=tid_in;i<1024;i+=512)tsl[i]=T.TS[i];
  for(;;){
    __syncthreads();
    if(tid_in==0)tsl[1024]=(int)__hip_atomic_fetch_add(T.queue,1u,__ATOMIC_RELAXED,__HIP_MEMORY_SCOPE_AGENT);
    __syncthreads();
    const int Lq=__builtin_amdgcn_readfirstlane(tsl[1024]); if(Lq>=X.total(BATCH*NHEAD*NQB))break;
    int L; if(X.map(Lq,L)){X.run(L);continue;}
    const int qb=NQB-1-(L>>6),bh=L&63;
    attn_unit<THRL>(tid_in,bh/NHEAD,bh%NHEAD,qb,__builtin_amdgcn_readfirstlane(tsl[bh*16+qb]),T.Q,T.K,T.V,T.O,T.FC+(long)bh*SEQ,lds);
  }
}
#undef SBAR
#undef WAIT_BAR
}

extern __shared__ __attribute__((aligned(16))) unsigned char lds_dyn[];
template <class Extra> __device__ __forceinline__ void attn_phase_call(int tid_in, const bf16* Up, bf16* Yp, const float* FCp, const int* TSp, unsigned* queue, int G, int vcu, const Extra& X) {
    const attn_body::AttnTensors AT{(const attn_body::bf16*)(Up + UC_Q), (const attn_body::bf16*)(Up + UC_K), (const attn_body::bf16*)(Up + UC_V), (attn_body::bf16*)Yp, FCp, TSp, queue};
    const attn_body::StaticOrder S(G, vcu);
    attn_body::attn_phase<attn_body::StaticOrder, Extra>(tid_in, (char*)lds_dyn + RING_OFF, AT, S, X);
}
__device__ __forceinline__ void router_phase(Frame& F, const float* R, const float* gain, const float* wg, const float* bg, const float* we, const float* be, bf16* XN, unsigned* cursor, int* perm, float* roww) {
    LAS float* Wr = (LAS float*)(F.lds);
    LAS int* rq = (LAS int*)(F.lds + 81920);
    LAS float* rw = (LAS float*)(F.lds + 81920 + 512);
    LAS int* lbase = (LAS int*)(F.lds + 81920 + 512 + 1024);
    __syncthreads();
    for (int e = F.tid; e < 20 * 1024; e += 512) { const int o = e >> 10, k = e & 1023; Wr[e] = o < 4 ? wg[k * 4 + o] : we[k * 16 + (o - 4)]; }
    f32x4 g[4];
#pragma unroll
    for (int j = 0; j < 4; ++j) g[j] = *((const f32x4*)gain + F.lane + 64 * j);
    float bias[20];
#pragma unroll
    for (int o = 0; o < 20; ++o) bias[o] = o < 4 ? bg[o] : be[o - 4];
    __syncthreads();
    for (int rb = F.vcu; rb < M / 128; rb += F.G) {
        for (int i = 0; i < 16; ++i) {
            const int rl = F.wave * 16 + i, m = rb * 128 + rl;
            const f32x4* xr = (const f32x4*)(R + (size_t)m * DM) + F.lane; f32x4 v[4]; float s = 0.f;
#pragma unroll
            for (int j = 0; j < 4; ++j) { v[j] = xr[64 * j]; s += (v[j].x * v[j].x + v[j].y * v[j].y) + (v[j].z * v[j].z + v[j].w * v[j].w); }
            const float rstd = __builtin_amdgcn_rsqf(wave_sum(s) * (1.f / DM) + EPS);
            unsigned long long* o8 = (unsigned long long*)(XN + (size_t)m * DM) + F.lane;
#pragma unroll
            for (int j = 0; j < 4; ++j) { v[j] = v[j] * rstd * g[j]; o8[64 * j] = (unsigned long long)pk2(v[j].x, v[j].y) | ((unsigned long long)pk2(v[j].z, v[j].w) << 32); }
            float lg[20];
#pragma unroll
            for (int o = 0; o < 20; ++o) { float a = 0.f;
#pragma unroll
                for (int j = 0; j < 4; ++j) { const f32x4 w = *(const LAS f32x4*)(Wr + o * 1024 + 4 * F.lane + 256 * j); a += (v[j].x * w.x + v[j].y * w.y) + (v[j].z * w.z + v[j].w * w.w); }
                lg[o] = wave_sum(a) + bias[o]; }
            int gi = 0; float gm = lg[0];
#pragma unroll
            for (int o = 1; o < 4; ++o) if (lg[o] > gm) { gm = lg[o]; gi = o; }
            const float gsum = __expf(lg[0] - gm) + __expf(lg[1] - gm) + __expf(lg[2] - gm) + __expf(lg[3] - gm);
            const float gval = 1.0f / gsum;
            float es[4];
#pragma unroll
            for (int j = 0; j < 4; ++j) es[j] = gi == 0 ? lg[4 + j] : gi == 1 ? lg[8 + j] : gi == 2 ? lg[12 + j] : lg[16 + j];
            int e1 = 0; float v1 = es[0];
#pragma unroll
            for (int j = 1; j < 4; ++j) if (es[j] > v1) { v1 = es[j]; e1 = j; }
            int e2 = -1; float v2 = -3.0e38f;
#pragma unroll
            for (int j = 0; j < 4; ++j) if (j != e1 && es[j] > v2) { v2 = es[j]; e2 = j; }
            const float ex = __expf(v2 - v1), w1 = gval / (1.f + ex), w2 = gval * ex / (1.f + ex);
            const int lo = e1 < e2 ? e1 : e2, hi = e1 < e2 ? e2 : e1;
            const int pidx = lo == 0 ? hi - 1 : (lo == 1 ? hi + 1 : 5);
            if (F.lane == 0) { rq[rl] = gi * 6 + pidx; rw[rl * 2] = e1 < e2 ? w1 : w2; rw[rl * 2 + 1] = e1 < e2 ? w2 : w1; }
        }
        __syncthreads();
        if (F.tid < NBUCKET) { int c = 0; for (int r = 0; r < 128; ++r) c += (rq[r] == F.tid) ? 1 : 0;
            lbase[F.tid] = c ? (int)__hip_atomic_fetch_add(cursor + 64 * F.tid, (unsigned)c, RLX_AGENT) : 0; }
        __syncthreads();
        if (F.tid < 128) { const int q = rq[F.tid]; int rank = 0; for (int r = 0; r < F.tid; ++r) rank += (rq[r] == q) ? 1 : 0;
            const int pos = lbase[q] + rank; perm[q * BCAP + pos] = rb * 128 + F.tid; roww[((size_t)q * BCAP + pos) * 2] = rw[F.tid * 2]; roww[((size_t)q * BCAP + pos) * 2 + 1] = rw[F.tid * 2 + 1]; }
        __syncthreads();
    }
}

__device__ __forceinline__ void router_phase2(Frame& F, const float* R, const float* gain, const float* wg, const float* bg, const float* we, const float* be, bf16* XN, unsigned* cursor, int* perm, float* roww, float* rstdo) {
    LAS bf16* Wh = (LAS bf16*)(F.lds); LAS bf16* Wl = Wh + 20 * 1024;
    LAS float* gs = (LAS float*)(F.lds + 81920);
    LAS float* lgs = (LAS float*)(F.lds + TBL_OFF);
    LAS int* rq = (LAS int*)(F.lds + TBL_OFF + 10240);
    LAS float* rw = (LAS float*)(F.lds + TBL_OFF + 10240 + 512);
    LAS int* lbase = (LAS int*)(F.lds + TBL_OFF + 10240 + 512 + 1024);
    LAS float* rs = (LAS float*)(F.lds + TBL_OFF + 12288);
    __syncthreads();
#pragma unroll
    for (int kk = 0; kk < 2; ++kk) { const int k = F.tid + 512 * kk;
        const f32x4 g4 = *(const f32x4*)(wg + k * 4), e0 = *(const f32x4*)(we + k * 16), e1 = *(const f32x4*)(we + k * 16 + 4), e2 = *(const f32x4*)(we + k * 16 + 8), e3 = *(const f32x4*)(we + k * 16 + 12); const float gk = gain[k];
        const float wv[20] = {g4.x, g4.y, g4.z, g4.w, e0.x, e0.y, e0.z, e0.w, e1.x, e1.y, e1.z, e1.w, e2.x, e2.y, e2.z, e2.w, e3.x, e3.y, e3.z, e3.w};
#pragma unroll
        for (int o = 0; o < 20; ++o) { const float w = wv[o] * gk; const unsigned hb = f2bf(w), lb = f2bf(w - bf2f(hb)); const int idx = o * 1024 + ((((k >> 3) ^ (o & 15)) << 3) | (k & 7)); Wh[idx] = (bf16)hb; Wl[idx] = (bf16)lb; } }
    for (int k = F.tid; k < 1024; k += 512) gs[k] = gain[k] * MOE_X_SCALE;
    const int fr = F.lane & 15, fq = F.lane >> 4;
    float bias0[4], bias1[4];
#pragma unroll
    for (int j = 0; j < 4; ++j) { const int o0 = 4 * fq + j, o1 = 16 + 4 * fq + j; bias0[j] = o0 < 4 ? bg[o0] : be[o0 - 4]; bias1[j] = o1 < 20 ? be[o1 - 4] : 0.f; }
    __syncthreads();
    for (int rb = F.vcu; rb < M / 128; rb += F.G) {
        const int rl = F.wave * 16 + fr; const size_t row = (size_t)rb * 128 + rl;
        const float* xr = R + row * DM + fq * 8;
        f32x4 acc0 = {0.f, 0.f, 0.f, 0.f}, acc1 = acc0; float ssq = 0.f;
        const int or0 = fr, or1 = (16 + fr) < 20 ? 16 + fr : 19;
#pragma unroll 4
        for (int ks = 0; ks < 32; ++ks) {
            const f32x4 xa = *(const f32x4*)(xr + ks * 32), xb = *(const f32x4*)(xr + ks * 32 + 4);
            ssq += (xa.x * xa.x + xa.y * xa.y) + (xa.z * xa.z + xa.w * xa.w) + (xb.x * xb.x + xb.y * xb.y) + (xb.z * xb.z + xb.w * xb.w);
            const v4u ahw = (v4u){pk2(xa.x, xa.y), pk2(xa.z, xa.w), pk2(xb.x, xb.y), pk2(xb.z, xb.w)};
            const v4u alw = (v4u){pk2(xa.x - bflo(ahw.x), xa.y - bfhi(ahw.x)), pk2(xa.z - bflo(ahw.y), xa.w - bfhi(ahw.y)), pk2(xb.x - bflo(ahw.z), xb.y - bfhi(ahw.z)), pk2(xb.z - bflo(ahw.w), xb.w - bfhi(ahw.w))};
            const bf16x8 ah = __builtin_bit_cast(bf16x8, ahw), al = __builtin_bit_cast(bf16x8, alw);
            const int c0 = ((ks * 4 + fq) ^ (or0 & 15)) << 3, c1 = ((ks * 4 + fq) ^ (or1 & 15)) << 3;
            const bf16x8 wh0 = *(const LAS bf16x8*)(Wh + or0 * 1024 + c0), wl0 = *(const LAS bf16x8*)(Wl + or0 * 1024 + c0);
            const bf16x8 wh1 = *(const LAS bf16x8*)(Wh + or1 * 1024 + c1), wl1 = *(const LAS bf16x8*)(Wl + or1 * 1024 + c1);
            acc0 = __builtin_amdgcn_mfma_f32_16x16x32_bf16(wh0, ah, acc0, 0, 0, 0); acc0 = __builtin_amdgcn_mfma_f32_16x16x32_bf16(wh0, al, acc0, 0, 0, 0); acc0 = __builtin_amdgcn_mfma_f32_16x16x32_bf16(wl0, ah, acc0, 0, 0, 0);
            acc1 = __builtin_amdgcn_mfma_f32_16x16x32_bf16(wh1, ah, acc1, 0, 0, 0); acc1 = __builtin_amdgcn_mfma_f32_16x16x32_bf16(wh1, al, acc1, 0, 0, 0); acc1 = __builtin_amdgcn_mfma_f32_16x16x32_bf16(wl1, ah, acc1, 0, 0, 0);
            { const f32x4 ga = *(const LAS f32x4*)(gs + ks * 32 + fq * 8), gb = *(const LAS f32x4*)(gs + ks * 32 + fq * 8 + 4);
              int o0 = 0, o1 = 0; o0 = __builtin_amdgcn_cvt_pk_fp8_f32(xa.x * ga.x, xa.y * ga.y, o0, false); o0 = __builtin_amdgcn_cvt_pk_fp8_f32(xa.z * ga.z, xa.w * ga.w, o0, true);
              o1 = __builtin_amdgcn_cvt_pk_fp8_f32(xb.x * gb.x, xb.y * gb.y, o1, false); o1 = __builtin_amdgcn_cvt_pk_fp8_f32(xb.z * gb.z, xb.w * gb.w, o1, true);
              *(v2u*)((unsigned char*)XN + row * DM + fq * 8 + ks * 32) = (v2u){(unsigned)o0, (unsigned)o1}; }
        }
        ssq += __builtin_bit_cast(float, __builtin_amdgcn_ds_bpermute((F.lane ^ 16) << 2, __builtin_bit_cast(int, ssq)));
        ssq += __builtin_bit_cast(float, __builtin_amdgcn_ds_bpermute((F.lane ^ 32) << 2, __builtin_bit_cast(int, ssq)));
        const float rstd = __builtin_amdgcn_rsqf(ssq * (1.f / DM) + EPS);
#pragma unroll
        for (int j = 0; j < 4; ++j) { lgs[rl * 20 + 4 * fq + j] = acc0[j] * rstd + bias0[j]; if (fq == 0) lgs[rl * 20 + 16 + j] = acc1[j] * rstd + bias1[j]; }
        if (fq == 0) rs[rl] = rstd;
        LDS_WAIT(); asm volatile("" ::: "memory");
        if (F.lane < 16) {
            const int tl = F.wave * 16 + F.lane; float lg[20];
#pragma unroll
            for (int o = 0; o < 20; ++o) lg[o] = lgs[tl * 20 + o];
            int gi = 0; float gm = lg[0];
#pragma unroll
            for (int o = 1; o < 4; ++o) if (lg[o] > gm) { gm = lg[o]; gi = o; }
            const float gsum = __expf(lg[0] - gm) + __expf(lg[1] - gm) + __expf(lg[2] - gm) + __expf(lg[3] - gm);
            const float gval = 1.0f / gsum;
            float es[4];
#pragma unroll
            for (int j = 0; j < 4; ++j) es[j] = gi == 0 ? lg[4 + j] : gi == 1 ? lg[8 + j] : gi == 2 ? lg[12 + j] : lg[16 + j];
            int e1 = 0; float v1 = es[0];
#pragma unroll
            for (int j = 1; j < 4; ++j) if (es[j] > v1) { v1 = es[j]; e1 = j; }
            int e2 = -1; float v2 = -3.0e38f;
#pragma unroll
            for (int j = 0; j < 4; ++j) if (j != e1 && es[j] > v2) { v2 = es[j]; e2 = j; }
            const float ex = __expf(v2 - v1), w1 = gval / (1.f + ex), w2 = gval * ex / (1.f + ex);
            const int lo = e1 < e2 ? e1 : e2, hi = e1 < e2 ? e2 : e1;
            const int pidx = lo == 0 ? hi - 1 : (lo == 1 ? hi + 1 : 5);
            rq[tl] = gi * 6 + pidx; rw[tl * 2] = e1 < e2 ? w1 : w2; rw[tl * 2 + 1] = e1 < e2 ? w2 : w1;
        }
        __syncthreads();
        int myq = 0, myrank = 0;
        if (F.tid < 128) { myq = rq[F.tid];
            const unsigned long long lt = (1ull << F.lane) - 1ull;
#pragma unroll 4
            for (int q = 0; q < NBUCKET; ++q) { const unsigned long long mk = __ballot(myq == q); if (myq == q) myrank = __builtin_popcountll(mk & lt); if (F.lane == 0) lbase[32 + F.wave * 32 + q] = __builtin_popcountll(mk); } }
        __syncthreads();
        if (F.tid < NBUCKET) { const int c0 = lbase[32 + F.tid], c1 = lbase[64 + F.tid], c = c0 + c1;
            lbase[F.tid] = c ? (int)__hip_atomic_fetch_add(cursor + 64 * F.tid, (unsigned)c, RLX_AGENT) : 0; }
        __syncthreads();
        if (F.tid < 128) { const int pos = lbase[myq] + myrank + (F.wave ? lbase[32 + myq] : 0); perm[myq * BCAP + pos] = rb * 128 + F.tid; roww[((size_t)myq * BCAP + pos) * 2] = rw[F.tid * 2]; roww[((size_t)myq * BCAP + pos) * 2 + 1] = rw[F.tid * 2 + 1]; rstdo[(size_t)myq * BCAP + pos] = rs[F.tid]; }
        __syncthreads();
    }
}

__device__ __forceinline__ void moe_tables(Frame& F, unsigned* cursor, const int* perm, int ntn, bool fused = false) {
    LAS int* tbl = (LAS int*)(F.lds + TBL_OFF);
    __syncthreads();
    if (F.tid < NBUCKET) { int c = (int)__hip_atomic_load(cursor + 64 * F.tid, RLX_AGENT); c = c < 0 ? 0 : (c > BCAP ? BCAP : c); tbl[F.tid] = c; }
    __syncthreads();
    if (F.tid == 0) { int T = 0;
        for (int q = 0; q < NBUCKET; ++q) { const int nt = (tbl[q] + 255) >> 8;
            for (int tb = 0; tb < nt && T < 192; ++tb) { tbl[32 + T] = q; tbl[32 + 192 + T] = tb; ++T; } }
        tbl[32 + 192 + 192] = T; }
    __syncthreads();
    {
        const int ttot = tbl[32 + 192 + 192];
        int tokv[TOK_UNITS];
#pragma unroll
        for (int i = 0; i < TOK_UNITS; ++i) { const int L = i * F.G + F.vcu; tokv[i] = 0;
            int mt = -1; if (fused) { if (L < ttot * 8) mt = L >> 3; else if (L < ttot * 12) mt = (L - ttot * 8) >> 2; } else if (L < ttot * ntn) mt = L / ntn;
            if (mt >= 0 && F.tid < 256) { const int q = tbl[32 + mt], tb = tbl[32 + 192 + mt], cnt = tbl[q]; int r = tb * 256 + F.tid; r = r < cnt ? r : cnt - 1; tokv[i] = perm[q * BCAP + r]; } }
#pragma unroll
        for (int i = 0; i < TOK_UNITS; ++i) { const int L = i * F.G + F.vcu; if (L < ttot * (fused ? 12 : ntn) && F.tid < 256) tbl[(TOK_OFF - TBL_OFF) / 4 + i * 256 + F.tid] = tokv[i]; }
        __syncthreads();
    }
}

constexpr int PH_PER_LAYER = 9, N_PHASES = 1 + DEPTH * PH_PER_LAYER;
__global__ void __launch_bounds__(512, 2) hybrid_fwd(Args args) {
    Frame F;
    F.lds = (LAS unsigned char*)lds_dyn;
    F.MISC = (volatile LAS unsigned*)(F.lds + MISC_OFF);
    F.tid = threadIdx.x; F.lane = F.tid & 63; F.wave = __builtin_amdgcn_readfirstlane(F.tid >> 6); F.wave0 = F.wave;
    F.G = gridDim.x; { const int bx = blockIdx.x; F.vcu = (F.G % 8 == 0) ? (bx % 8) * (F.G / 8) + bx / 8 : bx; F.vcu0 = F.vcu; F.G0 = F.G; }
    for (int u = F.tid; u < (LDS_BYTES - LDSCTL_OFF) / 4; u += 512) ((LAS unsigned*)(F.lds + LDSCTL_OFF))[u] = 0u;
    __syncthreads();
    if (F.tid < 26) { const unsigned long long pv = F.tid < 24 ? (unsigned long long)args.in[F.tid] : (F.tid == 24 ? (unsigned long long)args.ws : (unsigned long long)args.out);
        ((LAS unsigned*)(F.lds + PTAB_OFF))[2 * F.tid] = (unsigned)pv; ((LAS unsigned*)(F.lds + PTAB_OFF))[2 * F.tid + 1] = (unsigned)(pv >> 32); }
    __syncthreads();
    unsigned char* ws = (unsigned char*)inptr(F, 24);
    F.ctl = (gu32*)(ws + WS_CTL);
    XcdBarrier bar; bar.bar = (unsigned*)(F.ctl + CW_BAR); bar.x = 0; bar.st = nullptr;
    if (!MK_PER_PHASE) bar = xcd_barrier_post((unsigned*)(F.ctl + CW_BAR), F.MISC + 8);
#define GRID_BAR(seam) do { if (MK_PER_PHASE) { if (F.tid == 0) __hip_atomic_store(F.ctl + CW_TMO, 0xBADBA0u | (unsigned)(seam), RLX_AGENT); } else { xcd_barrier(bar); if (DUPN(14) > 1) xcd_barrier(bar); } } while (0)
    const int lo = args.ph_lo, hi = args.ph_hi;
#ifndef PREMIX_MASK
#define PREMIX_MASK 7
#endif
#ifndef MOE_FUSED
#define MOE_FUSED 1
#endif
#ifndef PHMASK
#define PHMASK 0x3ff
#endif
#define INM(j) ((PHMASK >> (j)) & 1)
#define IN(k) (lo <= (k) && (k) < hi && relaunder(F))
#define BOTH(k) (lo <= (k) && (k) + 1 < hi)
#define WSP ((unsigned char*)inptr(F, 24))
#define XN ((bf16*)(WSP + WS_XN))
#define Y ((bf16*)(WSP + WS_XN))
#define U ((bf16*)(WSP + WS_U))
#define H ((bf16*)(WSP + WS_U))
#define FD ((float*)(WSP + WS_FD))
#define FC ((float*)(WSP + WS_FC))
#define PERM ((int*)(WSP + WS_PERM))
#define ROWW ((float*)(WSP + WS_ROWW))
#define R ((float*)inptr(F, 25))

    if (IN(0) && INM(9)) { for (int rep = 0; rep < DUPN(9); ++rep) prologue_phase(F, WSP); if (BOTH(0)) GRID_BAR(0); }

#if USE_NAIVE_ATTN
#define ATTN_PHASE_CALL(l) attn_naive_phase(F, U, FC, Y)
#else
#define ATTN_PHASE_CALL(l) do { if ((l) == 0) { const MoeConvExtra X_{&F, WSP}; attn_phase_call(F.tid, U, (bf16*)(WSP + WS_XN8), FC, (const int*)(WSP + WS_CD + 65536), (unsigned*)(F.ctl + CW_ATQ + lp * 64), F.G, F.vcu, X_); } \
        else { const NoExtra X_{}; attn_phase_call(F.tid, U, (bf16*)(WSP + WS_XN8), FC, (const int*)(WSP + WS_CD + 65536), (unsigned*)(F.ctl + CW_ATQ + lp * 64), F.G, F.vcu, X_); } } while (0)
#endif
#if USE_NAIVE_SSD
#define NSSDU 16
#define SSD_A_UNITS() do { for (int it = F.vcu; it < NSSDU; it += F.G) { __syncthreads(); ssd_seq_unit(F, it, U, FD, Y, inptr(F, 8) + (size_t)lp * 4 * 768, inptr(F, 9) + (size_t)lp * 768, inptr(F, 10) + lp * 8, inptr(F, 11) + lp * 8, inptr(F, 12) + lp * 8); __syncthreads(); } } while (0)
#define SSD_SCAN() do { } while (0)
#define SSD_SCAN_WAIT() do { } while (0)
#define SSD_B_PHASE() ssd_norm_phase(F, Y, inptr(F, 13) + lp * 512)
#else
#define NSSDU 256
#define SSD_A_UNITS() do { const bf16* u_ = U; const float* fd_ = FD; float* sst_ = (float*)(WSP + WS_SST); float* cd_ = (float*)(WSP + WS_CD); \
        const float* p8_ = inptr(F, 8) + (size_t)lp * 4 * 768; const float* p9_ = inptr(F, 9) + (size_t)lp * 768; const float* p10_ = inptr(F, 10) + lp * 8; const float* p11_ = inptr(F, 11) + lp * 8; \
        for (int it = F.vcu; it < NSSDU; it += F.G) { for (int r2 = 0; r2 < DUPN(11); ++r2) ssd_passA_unit(F, it, u_, fd_, sst_, cd_, p8_, p9_, p10_, p11_); } } while (0)
#define SSD_SCAN() ssd_scan_phase(F, (const float*)(WSP + WS_SST), (const float*)(WSP + WS_CD), (bf16*)(WSP + WS_HPB), (unsigned*)(F.ctl + CW_SCN + lp * 64))
#define SSD_SCAN_WAIT() ssd_scan_wait(F, (unsigned*)(F.ctl + CW_SCN + lp * 64))
#define SSD_B_PHASE() do { const bf16* u_ = U; const float* fd_ = FD; const bf16* hpb_ = (const bf16*)(WSP + WS_HPB); bf16* y_ = Y; \
        const float* p8_ = inptr(F, 8) + (size_t)lp * 4 * 768; const float* p9_ = inptr(F, 9) + (size_t)lp * 768; const float* p10_ = inptr(F, 10) + lp * 8; const float* p11_ = inptr(F, 11) + lp * 8; const float* p12_ = inptr(F, 12) + lp * 8; const float* p13_ = inptr(F, 13) + lp * 512; \
        for (int it = F.vcu; it < 256; it += F.G) ssd_passB_unit(F, it, u_, fd_, hpb_, y_, p8_, p9_, p10_, p11_, p12_, p13_); } while (0)
#endif
#define LAYER_BODY(l) { \
        const int P = 1 + l * PH_PER_LAYER; \
        if (IN(P + 0) && INM(0)) { const int lp = opaque_s(l); \
            for (int rep = 0; rep < DUPN(0); ++rep) { \
                { DenseSched S{(const char*)(WSP + WS_WIN8) + (size_t)lp * NV_IN * DM, M / 256, NT8, DM, DM, F.G, opaque_s((int)blockIdx.x), 0}; \
                  EpiIn<true> E{U, FD}; \
                  if (DUPN(12) > 1) { GEMM_PHASE8(F, (const char*)(WSP + WS_XN8), DM / 128, DM, DM, S, E); relaunder(F); } GEMM_PHASE8(F, (const char*)(WSP + WS_XN8), DM / 128, DM, DM, S, E); } \
                relaunder(F); \
                { DenseSched S{(const char*)(WSP + WS_WIN) + ((size_t)lp * NV_IN + NT8 * 256) * DM * 2, M / 256, NV_IN / 256 - NT8, DM * 2, DM * 2, F.G, opaque_s((int)blockIdx.x), NT8}; \
                  EpiIn<false> E{U, FD}; \
                  if (DUPN(13) > 1) { GEMM_PHASE(F, (const char*)XN, DM * 2 / 128, DM * 2, DM * 2, S, E); relaunder(F); } GEMM_PHASE(F, (const char*)XN, DM * 2 / 128, DM * 2, DM * 2, S, E); } } \
            if (BOTH(P + 0)) GRID_BAR(P + 0); \
        } \
        if (IN(P + 1) && INM(1)) { const int lp = opaque_s(l); \
            for (int rep = 0; rep < DUPN(1); ++rep) { \
                SSD_A_UNITS(); \
                { const float* fd_ = FD; const float* p7_ = inptr(F, 7) + lp * 8; float* fc_ = FC; int* ts_ = (int*)(WSP + WS_CD + 65536); for (int it = F.vcu; it < 64; it += F.G) fcum_unit(F, it, fd_, p7_, fc_, ts_); } \
                for (int r2 = 0; r2 < DUPN(10); ++r2) { const int cfirst = (F.vcu + 64) % F.G; \
                    conv_units(F, cfirst, 1024, U, inptr(F, 3) + (size_t)lp * 31 * 512, inptr(F, 4) + lp * 512, inptr(F, 5) + lp * 512, inptr(F, 6) + lp * 512, Y); } \
            } \
            if (BOTH(P + 1)) GRID_BAR(P + 1); \
        } \
        if (IN(P + 2) && INM(2)) { const int lp = opaque_s(l); \
            SSD_SCAN(); \
            ATTN_PHASE_CALL(l); \
            SSD_SCAN_WAIT(); \
            SSD_B_PHASE(); \
            if (BOTH(P + 2)) GRID_BAR(P + 2); } \
        if (IN(P + 3) && INM(3)) { } \
        if (IN(P + 4) && INM(4)) { const int lp = opaque_s(l); \
            OutSched S{(const char*)(WSP + WS_WOUT) + (size_t)lp * DM * D_MIX * 2, (const char*)(WSP + WS_WOUT8) + (size_t)lp * DM * 512, (const char*)(WSP + WS_XN8), M / 256, DM / 256, D_MIX * 2, D_MIX * 2, F.G, opaque_s((int)blockIdx.x)}; \
            EpiOut E{lp == 0 ? inptr(F, 0) : (const float*)R, R}; \
            GEMM_PHASE(F, (const char*)Y, 20, D_MIX * 2, D_MIX * 2, S, E); \
            if (BOTH(P + 4)) GRID_BAR(P + 4); \
        } \
        if (IN(P + 5) && INM(5)) { const int lp = opaque_s(l); \
            router_phase2(F, R, inptr(F, 15) + lp * DM, inptr(F, 16) + (size_t)lp * DM * 4, inptr(F, 17) + lp * 4, inptr(F, 18) + (size_t)lp * DM * 16, inptr(F, 19) + lp * 16, XN, \
                         (unsigned*)(F.ctl + CW_CUR + lp * 2048), PERM, ROWW, (float*)(WSP + WS_RSTD)); \
            if (BOTH(P + 5)) GRID_BAR(P + 5); \
        } \
        if (MOE_FUSED) { \
        if (IN(P + 6) && INM(6)) { const int lp = opaque_s(l); \
            moe_tables(F, (unsigned*)(F.ctl + CW_CUR + lp * 2048), PERM, 12, true); \
            MoeSchedF S{(const LAS int*)(F.lds + TBL_OFF), PERM, (const char*)(WSP + WS_WGU) + (size_t)lp * NEXP * 1024 * 1024, (const char*)(WSP + WS_WD) + (size_t)lp * NEXP * 1024 * 512, \
                        (unsigned)WS_XN, (unsigned)WS_U, F.ctl + CW_HRDY + lp * 4096, F.ctl + CW_TMO, F.G, F.vcu}; \
            EpiF E{EpiGU_<true>{H, ROWW, (const float*)(WSP + WS_RSTD)}, EpiDown{R, PERM, (const LAS int*)(F.lds + TOK_OFF)}, F.ctl + CW_HRDY + lp * 4096}; \
            GEMM_PHASE8(F, (const char*)WSP, 8, 1024, 1024, S, E); \
            if (BOTH(P + 6)) GRID_BAR(P + 6); \
        } \
        } else { \
        if (IN(P + 6) && INM(6)) { const int lp = opaque_s(l); \
            moe_tables(F, (unsigned*)(F.ctl + CW_CUR + lp * 2048), PERM, 8); \
            MoeSched<false> S{(const LAS int*)(F.lds + TBL_OFF), PERM, (const char*)(WSP + WS_WGU) + (size_t)lp * NEXP * 1024 * 1024, 8, F.G, F.vcu}; \
            EpiGU E{H, ROWW, (const float*)(WSP + WS_RSTD)}; \
            for (int rep = 0; rep < DUPN(6); ++rep) GEMM_PHASE8(F, (const char*)XN, 8, 1024, 1024, S, E); \
            if (BOTH(P + 6)) GRID_BAR(P + 6); \
        } \
        if (IN(P + 7) && INM(7)) { const int lp = opaque_s(l); \
            moe_tables(F, (unsigned*)(F.ctl + CW_CUR + lp * 2048), PERM, 4); \
            MoeSched<true> S{(const LAS int*)(F.lds + TBL_OFF), PERM, (const char*)(WSP + WS_WD) + (size_t)lp * NEXP * 1024 * 512, 4, F.G, F.vcu}; \
            EpiDown E{R, PERM, (const LAS int*)(F.lds + TOK_OFF)}; \
            GEMM_PHASE8(F, (const char*)H, 8, 1024, 512, S, E); \
            if (BOTH(P + 7)) GRID_BAR(P + 7); \
        } \
        } \
        if (IN(P + 8) && INM(8)) { const int lp = opaque_s(l); \
            if (lp + 1 < DEPTH) { for (int rep = 0; rep < DUPN(8); ++rep) norm_rows_phase(F, R, inptr(F, 1) + (size_t)(lp + 1) * DM, XN, WSP + WS_XN8); if (BOTH(P + 8)) GRID_BAR(P + 8); } \
            else final_norm_phase(F, R, inptr(F, 23), R); \
        } \
    }
    LAYER_BODY(0)
    LAYER_BODY(1)
#undef LAYER_BODY
#undef ATTN_PHASE_CALL
#undef IN
#undef BOTH
#undef WSP
#undef XN
#undef Y
#undef U
#undef H
#undef FD
#undef FC
#undef PERM
#undef ROWW
#undef R
}

extern "C" void kernel_launch(void* const* d_in, const int* in_sizes, int n_in, void* d_out, int out_size, void* d_ws, size_t ws_size, hipStream_t stream) {
    static int grid = 0;
    if (grid == 0) {
        if (n_in != 24 || in_sizes[0] != M * DM || out_size != M * DM || ws_size < WS_END) { fprintf(stderr, "kernel_launch: unexpected shapes: n_in %d in0 %d out %d ws %zu (need %zu)\n", n_in, n_in > 0 ? in_sizes[0] : -1, out_size, ws_size, (size_t)WS_END); grid = -1; return; }
        int dev = 0, cus = 0, per_cu = 0;
        if (hipGetDevice(&dev) != hipSuccess || hipDeviceGetAttribute(&cus, hipDeviceAttributeMultiprocessorCount, dev) != hipSuccess) { grid = -1; return; }
        if (hipFuncSetAttribute((const void*)hybrid_fwd, hipFuncAttributeMaxDynamicSharedMemorySize, LDS_BYTES) != hipSuccess) { fprintf(stderr, "kernel_launch: hipFuncSetAttribute failed\n"); grid = -1; return; }
        if (hipOccupancyMaxActiveBlocksPerMultiprocessor(&per_cu, (const void*)hybrid_fwd, 512, LDS_BYTES) != hipSuccess || per_cu < 1) fprintf(stderr, "kernel_launch: occupancy query says %d\n", per_cu);
        (void)hipGetLastError();
        grid = cus;
    }
    if (grid < 0) return;
    if (hipMemsetAsync((char*)d_ws + WS_CTL, 0, CTL_ZERO_BYTES, stream) != hipSuccess) return;
    Args a{};
    for (int i = 0; i < 24; ++i) a.in[i] = (const float*)d_in[i];
    a.out = (float*)d_out; a.ws = (unsigned char*)d_ws; a.pad = 0;
#if MK_PER_PHASE
    for (int p = 0; p < N_PHASES; ++p) { a.ph_lo = p; a.ph_hi = p + 1; a.li = p; hipLaunchKernelGGL(hybrid_fwd, dim3(grid), dim3(512), LDS_BYTES, stream, a); }
#else
    a.ph_lo = 0; a.ph_hi = N_PHASES; a.li = 0;
    hipLaunchKernelGGL(hybrid_fwd, dim3(grid), dim3(512), LDS_BYTES, stream, a);
#endif
}
```

```cpp
#include <hip/hip_runtime.h>
#include <hip/hip_bf16.h>
#include <cstdio>
#include <cstdint>
#include <cmath>

#ifndef DUP_MASK
#define DUP_MASK 0
#endif
#define DUPN(j) (1 + ((DUP_MASK >> (j)) & 1))
#ifndef MK_PER_PHASE
#define MK_PER_PHASE 0
#endif

constexpr int NB = 8, SEQ = 4096, DM = 1024, M = NB * SEQ, DEPTH = 2;
constexpr int D_IN = 3856, D_MIX = 1536;
constexpr int NEXP = 16, DEXP = 512;
constexpr float EPS = 1e-6f;
constexpr float LOG2E = 1.4426950408889634f;
constexpr float C2 = 0.125f * LOG2E;
constexpr int UP = 3328, UC_GLU = 0, UC_Q = 512, UC_K = 1024, UC_V = 1536, UC_Z = 2048, UC_XS = 2560, UC_B = 3072, UC_C = 3200;
constexpr int YP = 1536, YC_CONV = 0, YC_ATT = 512, YC_SSD = 1024;
constexpr int NV_IN = 4096;
#ifndef NT8_IN
#define NT8_IN 10
#endif
constexpr int NT8 = NT8_IN;
constexpr float IN_X_SCALE = 8.f, IN_W_SCALE = 64.f, IN_DESCALE = 1.f / (IN_X_SCALE * IN_W_SCALE);
constexpr float OUT_Y_SCALE = 8.f, OUT_W_SCALE = 64.f; constexpr unsigned OUT_SCA = 0x7c7c7c7cu, OUT_SCB = 0x79797979u;
constexpr int NBUCKET = 24, BCAP = 32768;

constexpr size_t MiB = 1u << 20;
constexpr size_t WS_CTL = 0, CTL_ZERO_BYTES = 128 * 1024;
constexpr size_t WS_WIN = 1 * MiB;
constexpr size_t WS_WOUT = 17 * MiB;
constexpr size_t WS_WGU = 23 * MiB;
constexpr size_t WS_WD = 87 * MiB;
constexpr size_t WS_FD = 119 * MiB;
constexpr size_t WS_FC = 121 * MiB;
constexpr size_t WS_PERM = 122 * MiB;
constexpr size_t WS_ROWW = 125 * MiB;
constexpr size_t WS_SST = 131 * MiB;
constexpr size_t WS_XN = 165 * MiB;
constexpr size_t WS_U = 261 * MiB;
constexpr size_t WS_XN8 = 55 * MiB;
constexpr size_t WS_WIN8 = 103 * MiB;
constexpr size_t WS_WOUT8 = 114 * MiB;
constexpr size_t WS_RSTD = 111 * MiB;
constexpr size_t WS_END = 485 * MiB;
constexpr int CW_TMO = 0, CW_CODE = 1;
constexpr int CW_BAR = 4096;
constexpr int CW_ATQ = 20480;
constexpr int CW_SCN = 16384;
constexpr int CW_HRDY = 24576;
constexpr int CW_CUR = 8192;

constexpr int RING_OFF = 0, RING_BYTES = 131072;
constexpr int LDSCTL_OFF = RING_BYTES, MISC_OFF = LDSCTL_OFF + 320;
constexpr int TBL_OFF = LDSCTL_OFF + 1024;
constexpr int TOK_OFF = LDSCTL_OFF + 4096, TOK_UNITS = 12;
constexpr int LDS_BYTES = 147456;

#define GAS __attribute__((address_space(1)))
#define LAS __attribute__((address_space(3)))
typedef unsigned short bf16;
typedef unsigned v4u __attribute__((ext_vector_type(4)));
typedef unsigned v2u __attribute__((ext_vector_type(2)));
typedef float f32x4 __attribute__((ext_vector_type(4)));
typedef float f32x2 __attribute__((ext_vector_type(2)));
typedef short bf16x8 __attribute__((ext_vector_type(8)));
typedef GAS unsigned gu32;
#define RLX_AGENT __ATOMIC_RELAXED, __HIP_MEMORY_SCOPE_AGENT
#define LDS_WAIT() asm volatile("s_waitcnt lgkmcnt(0)" ::: "memory")
#define VM_WAIT() asm volatile("s_waitcnt vmcnt(0)" ::: "memory")
typedef __bf16 bf16x2_hw __attribute__((ext_vector_type(2)));
__device__ __forceinline__ unsigned pk2(float lo, float hi) { const f32x2 v = {lo, hi}; return __builtin_bit_cast(unsigned, __builtin_convertvector(v, bf16x2_hw)); }
__device__ __forceinline__ unsigned f2bf(float f) { return pk2(f, 0.f) & 0xffffu; }
__device__ __forceinline__ float bf2f(unsigned h) { return __builtin_bit_cast(float, h << 16); }
__device__ __forceinline__ float bflo(unsigned w) { return __builtin_bit_cast(float, w << 16); }
__device__ __forceinline__ float bfhi(unsigned w) { return __builtin_bit_cast(float, w & 0xffff0000u); }
__device__ __forceinline__ float sigmoidf_(float x) { return __builtin_amdgcn_rcpf(1.0f + __expf(-x)); }
__device__ __forceinline__ float siluf_(float x) { return x * sigmoidf_(x); }
#define swz_xor(v, pat) __builtin_bit_cast(float, __builtin_amdgcn_ds_swizzle(__builtin_bit_cast(int, (float)(v)), (pat)))
#define DPP_F(v, ctrl) __builtin_bit_cast(float, __builtin_amdgcn_mov_dpp(__builtin_bit_cast(int, (float)(v)), (ctrl), 0xf, 0xf, true))
__device__ __forceinline__ float wave_sum(float v) {
    v += DPP_F(v, 0xB1);
    v += DPP_F(v, 0x4E);
    v += DPP_F(v, 0x141);
    v += DPP_F(v, 0x140);
    const int vb = __builtin_bit_cast(int, v);
    return (__builtin_bit_cast(float, __builtin_amdgcn_readlane(vb, 0)) + __builtin_bit_cast(float, __builtin_amdgcn_readlane(vb, 16))) + (__builtin_bit_cast(float, __builtin_amdgcn_readlane(vb, 32)) + __builtin_bit_cast(float, __builtin_amdgcn_readlane(vb, 48)));
}
#define XB_TMO      128
#define XB_XCNT(j)  (256  + 64 * (j))
#define XB_XSUB(j)  (1280 + 64 * (j))
#define XB_XGEN(j)  (2304 + 64 * (j))
#define XB_TOP      3328
#define XB_TOPGEN   3392
#define XCD_BAR_WORDS 3456
#define XB_SPIN_CAP (1u << 18)
__device__ __forceinline__ unsigned xb_ld(unsigned* p)              { return __hip_atomic_load(p, __ATOMIC_RELAXED, __HIP_MEMORY_SCOPE_AGENT); }
__device__ __forceinline__ unsigned xb_add(unsigned* p, unsigned v) { return __hip_atomic_fetch_add(p, v, __ATOMIC_RELAXED, __HIP_MEMORY_SCOPE_AGENT); }
__device__ __forceinline__ unsigned xb_xcc_id() { return (unsigned)__builtin_amdgcn_s_getreg((3 << 11) | 20) & 0xFu; }
#define XB_SPIN(cond, bar) do { unsigned _sp = 0; while (cond) { __builtin_amdgcn_s_sleep(1); \
    if ((++_sp & 255u) == 0u) { if (xb_ld(&(bar)[XB_TMO])) break; if (_sp > XB_SPIN_CAP) { atomicAdd(&(bar)[XB_TMO], 1u); break; } } } } while (0)
struct XcdBarrier { unsigned* bar; unsigned x; volatile LAS unsigned* st; };
__device__ __forceinline__ XcdBarrier xcd_barrier_post(unsigned* bar, volatile LAS unsigned* st) {
    XcdBarrier b; b.bar = bar; b.x = xb_xcc_id(); b.st = st;
    if (threadIdx.x == 0) (void)xb_add(&bar[XB_XCNT(b.x)], 1u);
    return b;
}
__device__ __forceinline__ void xcd_barrier_complete(unsigned* bar, unsigned x, unsigned& nloc, unsigned& nx) {
    const unsigned G = gridDim.x * gridDim.y * gridDim.z;
    unsigned sum, cnt, mine, sp = 0u;
    for (;;) {
        sum = 0u; cnt = 0u; mine = 0u;
#pragma unroll
        for (unsigned j = 0; j < 16; ++j) { const unsigned c = xb_ld(&bar[XB_XCNT(j)]); sum += c; cnt += (c > 0u) ? 1u : 0u; mine = (j == x) ? c : mine; }
        if (sum == G) break;
        __builtin_amdgcn_s_sleep(1);
        if ((++sp & 255u) == 0u) { if (xb_ld(&bar[XB_TMO])) break; if (sp > XB_SPIN_CAP) { atomicAdd(&bar[XB_TMO], 1u); break; } }
    }
    nloc = mine > 0u ? mine : 1u; nx = cnt > 0u ? cnt : 1u;
}
__device__ __forceinline__ void xcd_barrier(const XcdBarrier& b) {
    asm volatile("s_waitcnt vmcnt(0)" ::: "memory");
    __syncthreads();
    if (threadIdx.x == 0) {
        unsigned* bar = b.bar; asm volatile("" : "+s"(bar));
        __builtin_amdgcn_s_waitcnt(0);
        unsigned nloc = b.st[0], nx = b.st[1];
        unsigned bx_ = b.x; asm volatile("" : "+s"(bx_));
        if (nloc == 0u) { xcd_barrier_complete(bar, bx_, nloc, nx); b.st[0] = nloc; b.st[1] = nx; }
        const unsigned old = xb_add(&bar[XB_XSUB(bx_)], 1u);
        const unsigned gen = old / nloc;
        if (old + 1u == (gen + 1u) * nloc) {
            __builtin_amdgcn_fence(__ATOMIC_RELEASE, "agent");
            asm volatile("s_waitcnt vmcnt(0)" ::: "memory");
            const unsigned og = xb_add(&bar[XB_TOP], 1u);
            const unsigned tg = og / nx;
            if (og + 1u == (tg + 1u) * nx) xb_add(&bar[XB_TOPGEN], 1u);
            else XB_SPIN(xb_ld(&bar[XB_TOPGEN]) == tg, bar);
            __builtin_amdgcn_fence(__ATOMIC_ACQUIRE, "agent");
            xb_add(&bar[XB_XGEN(bx_)], 1u);
            asm volatile("s_waitcnt vmcnt(0)" ::: "memory");
        } else {
            XB_SPIN(xb_ld(&bar[XB_XGEN(bx_)]) == gen, bar);
            __builtin_amdgcn_fence(__ATOMIC_ACQUIRE, "agent");
            asm volatile("s_waitcnt vmcnt(0)" ::: "memory");
        }
    }
    __syncthreads();
}

struct Args { const float* in[24]; float* out; unsigned char* ws; int ph_lo, ph_hi, li, pad; };
struct Frame {
    LAS unsigned char* lds;
    volatile LAS unsigned* MISC;
    gu32* ctl;
    int tid, lane, wave, vcu, G, wave0, vcu0, G0;
};

__device__ __forceinline__ int opaque_s(int v) { asm volatile("" : "+s"(v)); return v; }
__device__ __forceinline__ bool relaunder(Frame& F) { int w = F.wave0; asm volatile("" : "+s"(w)); int ln; asm volatile("v_mbcnt_lo_u32_b32 %0, -1, 0\n\tv_mbcnt_hi_u32_b32 %0, -1, %0" : "=v"(ln)); int t = w * 64 + ln; asm volatile("" : "+v"(t)); F.tid = t; F.lane = t & 63; F.wave = w; F.vcu = opaque_s(F.vcu0); F.G = opaque_s(F.G0); return true; }
constexpr int PTAB_OFF = LDSCTL_OFF + 512;
__device__ __forceinline__ const float* inptr(const Frame& F, int k) {
    const volatile LAS unsigned* p = (const volatile LAS unsigned*)(F.lds + PTAB_OFF) + 2 * k;
    const unsigned lo = __builtin_amdgcn_readfirstlane(p[0]), hi = __builtin_amdgcn_readfirstlane(p[1]);
    return (const float*)(const GAS float*)(((unsigned long long)hi << 32) | lo);
}
constexpr float MOE_X_SCALE = 8.f, MOE_WGU_SCALE = 64.f, MOE_H_SCALE = 8.f, MOE_WD_SCALE = 32.f;
constexpr float MOE_GU_DESCALE = 1.f / (MOE_X_SCALE * MOE_WGU_SCALE), MOE_DN_DESCALE = 1.f / (MOE_H_SCALE * MOE_WD_SCALE);
__host__ __device__ __forceinline__ int perm32(int rho) { const int n = rho >> 4, i = rho & 15; return 8 * (i >> 2) + 4 * n + (i & 3); }
struct Unit { int pm, pn, q, tb, cnt, ord, kind; };

#ifndef WGM_
#define WGM_ 8
#endif
struct DenseSched {
    static constexpr bool GATHER = false, FUSED = false, MIX = false;
    const char* Bt; int nM, nN, lda, ldb, G, c, pn0;
    __device__ __forceinline__ bool next(int i, Unit& u) const {
        const long L = (long)i * G + c; const int nwg = nM * nN; if (L >= nwg) return false;
        int wgid = (int)L; { const int q = nwg / 8, r = nwg % 8, xcd = wgid % 8, off = wgid / 8; wgid = (xcd < r ? xcd * (q + 1) : r * (q + 1) + (xcd - r) * q) + off; }
        const int nig = WGM_ * nN, gid = wgid / nig, fm = gid * WGM_, gsz = (nM - fm) < WGM_ ? (nM - fm) : WGM_;
        u.pm = fm + ((wgid % nig) % gsz); u.pn = pn0 + (wgid % nig) / gsz; u.q = 0; u.tb = 0; u.cnt = 0; u.ord = i; u.kind = 0; return true;
    }
    __device__ __forceinline__ unsigned a_rowoff(const Unit& u, int rloc) const { return (unsigned)(u.pm * 256 + rloc) * (unsigned)lda; }
    __device__ __forceinline__ size_t a_tile(const Unit& u) const { return (size_t)u.pm * 256 * lda; }
    __device__ __forceinline__ const char* b_tile(const Unit& u, int kt) const { return Bt + (size_t)(u.pn - pn0) * 256 * ldb + (size_t)kt * 128; }
};
struct OutSched {
    static constexpr bool GATHER = false, FUSED = false, MIX = true;
    const char* Bt; const char* Bt8; const char* A8; int nM, nN, lda, ldb, G, c;
    __device__ __forceinline__ bool next(int i, Unit& u) const {
        const long L = (long)i * G + c; const int nwg = nM * nN; if (L >= nwg) return false;
        int wgid = (int)L; { const int q = nwg / 8, r = nwg % 8, xcd = wgid % 8, off = wgid / 8; wgid = (xcd < r ? xcd * (q + 1) : r * (q + 1) + (xcd - r) * q) + off; }
        const int nig = WGM_ * nN, gid = wgid / nig, fm = gid * WGM_, gsz = (nM - fm) < WGM_ ? (nM - fm) : WGM_;
        u.pm = fm + ((wgid % nig) % gsz); u.pn = (wgid % nig) / gsz; u.q = 0; u.tb = 0; u.cnt = 0; u.ord = i; u.kind = 0; return true;
    }
    __device__ __forceinline__ unsigned a_rowoff(const Unit& u, int rloc) const { return (unsigned)(u.pm * 256 + rloc) * (unsigned)lda; }
    __device__ __forceinline__ size_t a_tile(const Unit& u) const { return (size_t)u.pm * 256 * lda; }
    static constexpr int K8_0 = 16;
    __device__ __forceinline__ bool is8(int kt) const { return kt >= K8_0; }
    __device__ __forceinline__ size_t a_koff(int kt) const { return kt < 8 ? (size_t)kt * 128 : (size_t)(kt - 8) * 128 + 2048; }
    __device__ __forceinline__ const char* b_tile(const Unit& u, int kt) const {
        if (is8(kt)) return Bt8 + (size_t)u.pn * 256 * 512 + (size_t)(kt - K8_0) * 128;
        return Bt + (size_t)u.pn * 256 * ldb + a_koff(kt);
    }
};
__device__ __forceinline__ void bucket_experts(int q, int& elo, int& ehi) { const int g = q / 6, p = q % 6; const int lo = p < 3 ? 0 : (p < 5 ? 1 : 2), hi = p < 3 ? p + 1 : (p < 5 ? p - 1 : 3); elo = 4 * g + lo; ehi = 4 * g + hi; }
template <bool down> struct MoeSched {
    static constexpr bool GATHER = !down, FUSED = false, MIX = false;
    __device__ __forceinline__ size_t a_tile(const Unit& u) const { return (size_t)u.pm * 256 * 1024; }
    const LAS int* tbl; const int* perm; const char* W; int NTN, G, c;
    __device__ __forceinline__ bool next(int i, Unit& u) const {
        const int L = i * G + c; const int ttot = __builtin_amdgcn_readfirstlane(tbl[32 + 192 + 192]); if (L >= ttot * NTN) return false;
        const int mt = L / NTN; u.pm = mt; u.pn = L % NTN; u.q = __builtin_amdgcn_readfirstlane(tbl[32 + mt]); u.tb = __builtin_amdgcn_readfirstlane(tbl[32 + 192 + mt]); u.cnt = __builtin_amdgcn_readfirstlane(tbl[u.q]); u.ord = i; u.kind = down ? 1 : 0; return true;
    }
    __device__ __forceinline__ unsigned a_rowoff(const Unit& u, int rloc) const {
        if (down) return (unsigned)(u.pm * 256 + rloc) * 1024u;
        if (u.ord < TOK_UNITS) return (unsigned)tbl[(TOK_OFF - TBL_OFF) / 4 + u.ord * 256 + rloc] * 1024u;
        int r = u.tb * 256 + rloc; r = r < u.cnt ? r : u.cnt - 1;
        return (unsigned)perm[u.q * BCAP + r] * 1024u;
    }
    __device__ __forceinline__ const char* b_tile(const Unit& u, int kt) const {
        int elo, ehi; bucket_experts(u.q, elo, ehi);
        if (!down) { const int e = (u.pn >> 2) ? ehi : elo; return W + (size_t)e * 1024 * 1024 + (size_t)(u.pn & 3) * 256 * 1024 + (size_t)kt * 128; }
        const int e = kt < 4 ? elo : ehi; return W + (size_t)e * 1024 * 512 + (size_t)u.pn * 256 * 512 + (size_t)(kt & 3) * 128;
    }
};

struct MoeSchedF {
    static constexpr bool GATHER = true, FUSED = true, MIX = false;
    const LAS int* tbl; const int* perm; const char* Wgu; const char* Wd; unsigned offX, offH; gu32* rdy; gu32* tmo; int G, c;
    __device__ __forceinline__ size_t a_tile(const Unit&) const { return 0; }
    __device__ __forceinline__ bool next(int i, Unit& u) const {
        const int L = i * G + c; const int ttot = __builtin_amdgcn_readfirstlane(tbl[32 + 192 + 192]); if (L >= ttot * 12) return false;
        int mt; if (L < ttot * 8) { u.kind = 0; mt = L >> 3; u.pn = L & 7; } else { const int L2 = L - ttot * 8; u.kind = 1; mt = L2 >> 2; u.pn = L2 & 3; }
        u.pm = mt; u.q = __builtin_amdgcn_readfirstlane(tbl[32 + mt]); u.tb = __builtin_amdgcn_readfirstlane(tbl[32 + 192 + mt]); u.cnt = __builtin_amdgcn_readfirstlane(tbl[u.q]); u.ord = i; return true;
    }
    __device__ __forceinline__ unsigned a_rowoff(const Unit& u, int rloc) const {
        if (u.kind) return offH + (unsigned)(u.pm * 256 + rloc) * 1024u;
        if (u.ord < TOK_UNITS) return offX + (unsigned)tbl[(TOK_OFF - TBL_OFF) / 4 + u.ord * 256 + rloc] * 1024u;
        int r = u.tb * 256 + rloc; r = r < u.cnt ? r : u.cnt - 1;
        return offX + (unsigned)perm[u.q * BCAP + r] * 1024u;
    }
    __device__ __forceinline__ const char* b_tile(const Unit& u, int kt) const {
        int elo, ehi; bucket_experts(u.q, elo, ehi);
        if (!u.kind) { const int e = (u.pn >> 2) ? ehi : elo; return Wgu + (size_t)e * 1024 * 1024 + (size_t)(u.pn & 3) * 256 * 1024 + (size_t)kt * 128; }
        const int e = kt < 4 ? elo : ehi; return Wd + (size_t)e * 1024 * 512 + (size_t)u.pn * 256 * 512 + (size_t)(kt & 3) * 128;
    }
    __device__ __forceinline__ int ldb_of(const Unit& u) const { return u.kind ? 512 : 1024; }
    __device__ __forceinline__ bool perm_of(const Unit& u) const { return !u.kind; }
    __device__ __forceinline__ void publish(int pm, int) const { const int ln = __builtin_amdgcn_mbcnt_hi(-1, __builtin_amdgcn_mbcnt_lo(-1, 0)); if (ln == 0) __hip_atomic_fetch_add(rdy + __builtin_amdgcn_readfirstlane(pm) * 16, 1u, RLX_AGENT); }
    __device__ __forceinline__ void a_wait(const Unit& u) const {
        if (!u.kind) return;
        gu32* p = rdy + u.pm * 16; unsigned sp = 0;
        while (__hip_atomic_load(p, RLX_AGENT) < 64u) { __builtin_amdgcn_s_sleep(2); if (++sp > (1u << 21)) { __hip_atomic_store(tmo, 0xF05Eu, RLX_AGENT); break; } }
    }
};

namespace pg8 {
constexpr int HALF = 128, HTB = HALF * 64 * 2;
__device__ __forceinline__ int lds_byte(int r, int c) { const int st = (r >> 4) * 2 + (c >> 5), rr = r & 15, cc = c & 31, ob = rr * 64 + cc * 2; return st * 1024 + (ob ^ (((ob >> 9) & 1) << 5)); }
__device__ __forceinline__ void stage_rc(int b, int& R, int& C) { const int st = b / 1024, sb = b % 1024, swz = sb ^ (((sb >> 9) & 1) << 5); R = (st >> 1) * 16 + swz / 64; C = (st & 1) * 32 + (swz % 64) / 2; }
template <class Epi, class Sched, bool ALIGN_EPI, bool FP8>
__device__ __forceinline__ void gemm_phase(LAS unsigned char* lds, int tid, const char* Abase, int nt, int lda, int ldb, const Sched& S, const Epi& E) {
    const int wid = __builtin_amdgcn_readfirstlane(tid >> 6), lane = tid & 63, wr = wid >> 2, wc = wid & 3, fr = lane & 15, fq = lane >> 4;
    unsigned voffB[2], voffA[2];
#pragma unroll
    for (int i = 0; i < 2; ++i) { int sR, sC; stage_rc(tid * 16 + i * 8192, sR, sC); const int Rb = Epi::PERM ? ((sR & ~31) + perm32(sR & 31)) : sR; voffB[i] = (unsigned)(Rb * ldb + sC * 2); voffA[i] = (unsigned)(sR * lda + sC * 2); }
    size_t hstepB = (size_t)HALF * ldb; const size_t hstepA = (size_t)HALF * lda;
    constexpr bool TUP = FP8 || Sched::MIX;
    unsigned voff8[2] = {0u, 0u};
    if constexpr (Sched::MIX) {
#pragma unroll
        for (int i = 0; i < 2; ++i) { int sR, sC; stage_rc(tid * 16 + i * 8192, sR, sC); voff8[i] = (unsigned)(sR * 512 + sC * 2); } }
    const unsigned xA0 = voffA[0] ^ voff8[0], xA1 = voffA[1] ^ voff8[1], xB0 = voffB[0] ^ voff8[0], xB1 = voffB[1] ^ voff8[1];
#define PG8_SETB(un) do { const int ldb_ = S.ldb_of(un); const bool pf_ = S.perm_of(un); _Pragma("unroll") for (int _i = 0; _i < 2; ++_i) { int sR, sC; stage_rc(tid * 16 + _i * 8192, sR, sC); \
        const int Rb = pf_ ? ((sR & ~31) + perm32(sR & 31)) : sR; voffB[_i] = (unsigned)(Rb * ldb_ + sC * 2); } hstepB = (size_t)HALF * ldb_; } while (0)
    const unsigned ldsw = (unsigned)wid * 1024u;
    const int aoff = lds_byte(wr * 64 + fr, fq * 8), boff = lds_byte(wc * 32 + fr, fq * 8);
#define PG8_SA(b, h) (((b) * 2 + (h)) * pg8::HTB)
#define PG8_SB(b, h) ((4 + (b) * 2 + (h)) * pg8::HTB)
#define PG8_STAGE_A(bufoff, sel, kt, h) do { if constexpr (Sched::GATHER) { const char* g_ = Abase + (size_t)(kt) * 128; _Pragma("unroll") for (int _i = 0; _i < 2; ++_i) { const unsigned vo_ = vc[h][_i]; \
        __builtin_amdgcn_global_load_lds((const unsigned*)(g_ + vo_), (LAS unsigned*)(lds + (bufoff) + ldsw + _i * 8192), 16, 0, 0); } } else if constexpr (Sched::MIX) { \
        const bool k8_ = S.is8(kt); const char* g_ = k8_ ? S.A8 + (size_t)((sel) ? nxt.pm : cur.pm) * 131072 + (h) * 65536 + (size_t)((kt) - Sched::K8_0) * 128 : Abase + ((sel) ? nA : cA) + (h) * hstepA + S.a_koff(kt); \
        const unsigned mk_ = k8_ ? 0xffffffffu : 0u; unsigned v0_ = voffA[0] ^ (xA0 & mk_), v1_ = voffA[1] ^ (xA1 & mk_); asm volatile("" : "+v"(v0_), "+v"(v1_));     \
        __builtin_amdgcn_global_load_lds((const unsigned*)(g_ + v0_), (LAS unsigned*)(lds + (bufoff) + ldsw), 16, 0, 0); \
        __builtin_amdgcn_global_load_lds((const unsigned*)(g_ + v1_), (LAS unsigned*)(lds + (bufoff) + ldsw + 8192), 16, 0, 0); } else { \
        const char* g_ = Abase + ((sel) ? nA : cA) + (h) * hstepA + (size_t)(kt) * 128; _Pragma("unroll") for (int _i = 0; _i < 2; ++_i) \
        __builtin_amdgcn_global_load_lds((const unsigned*)(g_ + voffA[_i]), (LAS unsigned*)(lds + (bufoff) + ldsw + _i * 8192), 16, 0, 0); } } while (0)
#define PG8_STAGE_B(bufoff, bptr, h, k8) do { if constexpr (Sched::MIX) { const bool k8_ = (k8); const char* g_ = (bptr) + (h) * (k8_ ? (size_t)65536 : hstepB); const unsigned mk_ = k8_ ? 0xffffffffu : 0u; unsigned v0_ = voffB[0] ^ (xB0 & mk_), v1_ = voffB[1] ^ (xB1 & mk_); asm volatile("" : "+v"(v0_), "+v"(v1_)); \
        __builtin_amdgcn_global_load_lds((const unsigned*)(g_ + v0_), (LAS unsigned*)(lds + (bufoff) + ldsw), 16, 0, 0); \
        __builtin_amdgcn_global_load_lds((const unsigned*)(g_ + v1_), (LAS unsigned*)(lds + (bufoff) + ldsw + 8192), 16, 0, 0); } else { \
        const char* g_ = (bptr) + (h) * hstepB; _Pragma("unroll") for (int _i = 0; _i < 2; ++_i) \
        __builtin_amdgcn_global_load_lds((const unsigned*)(g_ + voffB[_i]), (LAS unsigned*)(lds + (bufoff) + ldsw + _i * 8192), 16, 0, 0); } } while (0)
#define PG8_LDA(dst, b, h) do { if constexpr (TUP) { _Pragma("unroll") for (int m = 0; m < 4; ++m) { const v4u lo_ = *(const LAS v4u*)(lds + PG8_SA(b, h) + aoff + m * 2048), hi_ = *(const LAS v4u*)(lds + PG8_SA(b, h) + aoff + m * 2048 + 1024); dst##8[m] = __builtin_shufflevector(lo_, hi_, 0, 1, 2, 3, 4, 5, 6, 7); } } else { \
        _Pragma("unroll") for (int m = 0; m < 4; ++m) _Pragma("unroll") for (int k = 0; k < 2; ++k) dst[m][k] = *(const LAS bf16x8*)(lds + PG8_SA(b, h) + aoff + m * 2048 + k * 1024); } } while (0)
#define PG8_LDB(dst, b, h) do { if constexpr (TUP) { _Pragma("unroll") for (int n = 0; n < 2; ++n) { const v4u lo_ = *(const LAS v4u*)(lds + PG8_SB(b, h) + boff + n * 2048), hi_ = *(const LAS v4u*)(lds + PG8_SB(b, h) + boff + n * 2048 + 1024); dst##8[n] = __builtin_shufflevector(lo_, hi_, 0, 1, 2, 3, 4, 5, 6, 7); } } else { \
        _Pragma("unroll") for (int n = 0; n < 2; ++n) _Pragma("unroll") for (int k = 0; k < 2; ++k) dst[n][k] = *(const LAS bf16x8*)(lds + PG8_SB(b, h) + boff + n * 2048 + k * 1024); } } while (0)
#define PG8_SUB0(x) __builtin_bit_cast(bf16x8, __builtin_shufflevector(x, x, 0, 1, 2, 3))
#define PG8_SUB1(x) __builtin_bit_cast(bf16x8, __builtin_shufflevector(x, x, 4, 5, 6, 7))
#define PG8_MMA(ai, bj, At, Bt) do { __builtin_amdgcn_s_setprio(1); if constexpr (FP8) { _Pragma("unroll") for (int m = 0; m < 4; ++m) _Pragma("unroll") for (int n = 0; n < 2; ++n) \
        asm volatile("v_mfma_scale_f32_16x16x128_f8f6f4 %0, %1, %2, %0, %3, %3 op_sel_hi:[0,0,0]" : "+v"(acc[ai][bj][m][n]) : "v"(Bt##8[n]), "v"(At##8[m]), "v"(sc8)); } else { \
        _Pragma("unroll") for (int m = 0; m < 4; ++m) _Pragma("unroll") for (int n = 0; n < 2; ++n) _Pragma("unroll") for (int k = 0; k < 2; ++k) \
        acc[ai][bj][m][n] = __builtin_amdgcn_mfma_f32_16x16x32_bf16(Bt[n][k], At[m][k], acc[ai][bj][m][n], 0, 0, 0); } __builtin_amdgcn_s_setprio(0); } while (0)
#define PG8_PIN(At, Bt) do { _Pragma("unroll") for (int m = 0; m < 4; ++m) asm volatile("" : "+v"(At##8[m])); _Pragma("unroll") for (int n = 0; n < 2; ++n) asm volatile("" : "+v"(Bt##8[n])); } while (0)
#define PG8_MMA8S(ai, bj, At, Bt) do { __builtin_amdgcn_s_setprio(1); _Pragma("unroll") for (int m = 0; m < 4; ++m) _Pragma("unroll") for (int n = 0; n < 2; ++n) \
        asm volatile("v_mfma_scale_f32_16x16x128_f8f6f4 %0, %1, %2, %0, %3, %4 op_sel_hi:[0,0,0]" : "+v"(acc[ai][bj][m][n]) : "v"(Bt##8[n]), "v"(At##8[m]), "v"(scB8), "v"(scA8)); __builtin_amdgcn_s_setprio(0); } while (0)
#define PG8_MMAB(ai, bj, At, Bt) do { __builtin_amdgcn_s_setprio(1); _Pragma("unroll") for (int m = 0; m < 4; ++m) _Pragma("unroll") for (int n = 0; n < 2; ++n) { \
        acc[ai][bj][m][n] = __builtin_amdgcn_mfma_f32_16x16x32_bf16(PG8_SUB0(Bt##8[n]), PG8_SUB0(At##8[m]), acc[ai][bj][m][n], 0, 0, 0); \
        acc[ai][bj][m][n] = __builtin_amdgcn_mfma_f32_16x16x32_bf16(PG8_SUB1(Bt##8[n]), PG8_SUB1(At##8[m]), acc[ai][bj][m][n], 0, 0, 0); } __builtin_amdgcn_s_setprio(0); } while (0)
#define PG8_WAIT_V(n) asm volatile("s_waitcnt vmcnt(" #n ")" ::: "memory")
#define PG8_WAIT_L(n) asm volatile("s_waitcnt lgkmcnt(" #n ")" ::: "memory")
#define PG8_BAR __builtin_amdgcn_s_barrier()
#define PG8_SCHED __builtin_amdgcn_sched_barrier(0)
#define PG8_VOFFS(dst, un) do { if constexpr (Sched::GATHER) { _Pragma("unroll") for (int _i = 0; _i < 2; ++_i) { int sR, sC; stage_rc(tid * 16 + _i * 8192, sR, sC); _Pragma("unroll") for (int _h = 0; _h < 2; ++_h) dst[_h][_i] = S.a_rowoff(un, _h * 128 + sR) + (unsigned)sC * 2u; } } } while (0)
#define PG8_BODY(MM) PG8_LDB(B0, 0, 0); PG8_LDB(B1, 0, 1); PG8_SCHED; PG8_LDA(At, 0, 0); PG8_STAGE_A(PG8_SA(1, 1), false, t + 1, 1); \
            PG8_WAIT_V(8); PG8_WAIT_L(0); PG8_BAR; MM(0, 0, At, B0); MM(0, 1, At, B1); PG8_BAR; PG8_SCHED; \
            if constexpr (Sched::GATHER) { if (last && has_next) { PG8_VOFFS(vc, nxt); } } \
            PG8_LDA(At, 0, 1); PG8_STAGE_B(PG8_SB(0, 0), b2, 0, k82); PG8_STAGE_B(PG8_SB(0, 1), b2, 1, k82); PG8_STAGE_A(PG8_SA(0, 0), last, kt2, 0); \
            PG8_WAIT_V(8); PG8_WAIT_L(0); PG8_BAR; MM(1, 0, At, B0); MM(1, 1, At, B1); PG8_BAR; PG8_SCHED; \
            PG8_LDB(B0, 1, 0); PG8_LDB(B1, 1, 1); PG8_SCHED; PG8_LDA(At, 1, 0); PG8_STAGE_A(PG8_SA(0, 1), last, kt2, 1); \
            PG8_WAIT_V(8); PG8_WAIT_L(0); PG8_BAR; MM(0, 0, At, B0); MM(0, 1, At, B1); PG8_BAR; PG8_SCHED; \
            PG8_LDA(At, 1, 1); PG8_STAGE_B(PG8_SB(1, 0), b3, 0, k82); PG8_STAGE_B(PG8_SB(1, 1), b3, 1, k82); PG8_STAGE_A(PG8_SA(1, 0), last, kt2 + 1, 0); \
            PG8_WAIT_V(8); PG8_WAIT_L(0); PG8_BAR; MM(1, 0, At, B0); MM(1, 1, At, B1); PG8_BAR; PG8_SCHED;
    Unit cur, nxt; int ui = 0; int pend = -1;
    if (!S.next(0, cur)) return;
    f32x4 acc[2][2][4][2];
    typedef unsigned v8u_t __attribute__((ext_vector_type(8))); typedef int v8i_t __attribute__((ext_vector_type(8)));
    bf16x8 At[4][2], B0[2][2], B1[2][2]; v8u_t At8[4], B08[2], B18[2]; unsigned sc8 = 0x7f7f7f7fu; asm volatile("" : "+v"(sc8)); unsigned scA8 = OUT_SCA, scB8 = OUT_SCB; asm volatile("" : "+v"(scA8), "+v"(scB8));
    unsigned vc[2][2] = {{0u, 0u}, {0u, 0u}};
    size_t cA = S.a_tile(cur), nA = cA;
    if constexpr (Sched::FUSED) { S.a_wait(cur); PG8_SETB(cur); }
    PG8_VOFFS(vc, cur);
    { const char* bp0 = S.b_tile(cur, 0); const char* bp1 = S.b_tile(cur, 1);
      PG8_WAIT_L(0);
      PG8_STAGE_B(PG8_SB(0, 0), bp0, 0, false); PG8_STAGE_B(PG8_SB(0, 1), bp0, 1, false); PG8_STAGE_A(PG8_SA(0, 0), false, 0, 0); PG8_STAGE_A(PG8_SA(0, 1), false, 0, 1);
      if (wr == 1) PG8_BAR;
      PG8_WAIT_V(2); PG8_BAR;
      PG8_STAGE_B(PG8_SB(1, 0), bp1, 0, false); PG8_STAGE_A(PG8_SA(1, 0), false, 1, 0); PG8_STAGE_B(PG8_SB(1, 1), bp1, 1, false);
      PG8_WAIT_V(6); PG8_BAR; }
    { float zz = 0.f; asm volatile("" : "+v"(zz));
#pragma unroll
    for (int a = 0; a < 2; ++a)
#pragma unroll
        for (int b = 0; b < 2; ++b)
#pragma unroll
            for (int m = 0; m < 4; ++m)
#pragma unroll
                for (int n = 0; n < 2; ++n) acc[a][b][m][n] = (f32x4){zz, zz, zz, zz}; }
    for (;;) {
        const bool has_next = S.next(ui + 1, nxt);
        if (has_next) { nA = S.a_tile(nxt); } else { nxt = cur; nA = cA; }
        PG8_WAIT_L(0);
#define PG8_KLOOP(T0, T1, BODYSEL) _Pragma("unroll 1") for (int t = (T0); t < (T1); t += 2) { \
            const bool last = (t == nt - 2); \
            const int kt2 = last ? 0 : t + 2; \
            const char* b2 = last ? S.b_tile(nxt, 0) : S.b_tile(cur, kt2); \
            const char* b3 = last ? S.b_tile(nxt, 1) : S.b_tile(cur, kt2 + 1); \
            bool k82 = false; if constexpr (Sched::MIX) { k82 = !last && S.is8(kt2); } \
            BODYSEL; }
        if constexpr (Sched::MIX) { PG8_KLOOP(0, Sched::K8_0, PG8_BODY(PG8_MMAB)) PG8_KLOOP(Sched::K8_0, nt, PG8_BODY(PG8_MMA8S)) } else {
#pragma unroll 1
        for (int t = 0; t < nt; t += 2) {
            const bool last = (t == nt - 2);
            const int kt2 = last ? 0 : t + 2;
            const char* b2 = last ? S.b_tile(nxt, 0) : S.b_tile(cur, kt2);
            const char* b3 = last ? S.b_tile(nxt, 1) : S.b_tile(cur, kt2 + 1);
            bool m8 = false, k82 = false; if constexpr (Sched::MIX) { m8 = S.is8(t); k82 = !last && S.is8(kt2); }
            if constexpr (Sched::FUSED) { if (t == 2 && pend >= 0) { S.publish(pend, lane); pend = -1; }
                if (last && has_next) { S.a_wait(nxt); if (nxt.kind != cur.kind) PG8_SETB(nxt); } }
            PG8_BODY(PG8_MMA);
        } }
        if constexpr (ALIGN_EPI) { if (wr == 0) PG8_BAR; }
        if constexpr (FP8 || Sched::MIX) asm volatile("s_nop 15\n\ts_nop 15" ::: "memory");
        E(acc, cur, wr, wc, fr, fq);
        if constexpr (Sched::FUSED) { if (cur.kind == 0) pend = cur.pm; }
        if (!has_next) break;
        { float zz = 0.f; asm volatile("" : "+v"(zz));
#pragma unroll
        for (int a = 0; a < 2; ++a)
#pragma unroll
            for (int b = 0; b < 2; ++b)
#pragma unroll
                for (int m = 0; m < 4; ++m)
#pragma unroll
                    for (int n = 0; n < 2; ++n) acc[a][b][m][n] = (f32x4){zz, zz, zz, zz}; }
        cur = nxt; cA = nA; ++ui;
        if constexpr (ALIGN_EPI) { if (wr == 1) PG8_BAR; }
    }
    PG8_WAIT_V(0);
    if constexpr (Sched::FUSED) { if (pend >= 0) S.publish(pend, lane); }
    if constexpr (!ALIGN_EPI) { if (wr == 0) PG8_BAR; }
    PG8_BAR;
#undef PG8_SA
#undef PG8_SB
#undef PG8_STAGE_A
#undef PG8_STAGE_B
#undef PG8_LDA
#undef PG8_LDB
#undef PG8_MMA
#undef PG8_MMA8S
#undef PG8_PIN
#undef PG8_MMAB
#undef PG8_BODY
#undef PG8_KLOOP
#undef PG8_SUB0
#undef PG8_SUB1
#undef PG8_WAIT_V
#undef PG8_WAIT_L
#undef PG8_BAR
#undef PG8_SCHED
#undef PG8_VOFFS
#undef PG8_SETB
}
}
#ifndef FOX_FIXED_REF
#define FOX_FIXED_REF 1
#endif
#ifndef USE_NAIVE_SSD
#define USE_NAIVE_SSD 0
#endif
#ifndef USE_NAIVE_ATTN
#define USE_NAIVE_ATTN 0
#endif
#define GEMM_PHASE(F, Abase, nt, ldaB, ldbB, S, E) pg8::gemm_phase<__typeof__(E), __typeof__(S), true, false>(F.lds + RING_OFF, F.tid, Abase, nt, ldaB, ldbB, S, E)
#define GEMM_PHASE8(F, Abase, nt, ldaB, ldbB, S, E) pg8::gemm_phase<__typeof__(E), __typeof__(S), true, true>(F.lds + RING_OFF, F.tid, Abase, nt, ldaB, ldbB, S, E)

template <bool F8> struct EpiIn {
    static constexpr bool PERM = true;
    static constexpr float DS = F8 ? IN_DESCALE : 1.0f;
    bf16* U; float* FD;
    __device__ __forceinline__ void operator()(const f32x4 (&acc)[2][2][4][2], const Unit& u, int wr, int wc, int fr, int fq) const {
        const int row0 = u.pm * 256 + wr * 64 + fr;
        if (u.pn < 4) {
#pragma unroll
            for (int ai = 0; ai < 2; ++ai)
#pragma unroll
                for (int m = 0; m < 4; ++m) { bf16* rowp = U + (size_t)(row0 + ai * 128 + m * 16) * UP + UC_GLU + u.pn * 128 + wc * 16 + fq * 4;
#pragma unroll
                    for (int bj = 0; bj < 2; ++bj) { const f32x4 a = F8 ? acc[ai][bj][m][0] * DS : acc[ai][bj][m][0], g = F8 ? acc[ai][bj][m][1] * DS : acc[ai][bj][m][1];
                        v2u w; w.x = pk2(a[0] * sigmoidf_(g[0]), a[1] * sigmoidf_(g[1])); w.y = pk2(a[2] * sigmoidf_(g[2]), a[3] * sigmoidf_(g[3]));
                        *(v2u*)(rowp + bj * 64) = w; } }
        } else if (u.pn < 15) {
            const float sc = (u.pn < 6 ? C2 : 1.0f) * DS;
            const int col0 = 512 + (u.pn - 4) * 256 + wc * 32 + fq * 8;
#pragma unroll
            for (int ai = 0; ai < 2; ++ai)
#pragma unroll
                for (int m = 0; m < 4; ++m) { bf16* rowp = U + (size_t)(row0 + ai * 128 + m * 16) * UP + col0;
#pragma unroll
                    for (int bj = 0; bj < 2; ++bj) { const f32x4 v0 = acc[ai][bj][m][0] * sc, v1 = acc[ai][bj][m][1] * sc;
                        v4u w; w.x = pk2(v0[0], v0[1]); w.y = pk2(v0[2], v0[3]); w.z = pk2(v1[0], v1[1]); w.w = pk2(v1[2], v1[3]);
                        *(v4u*)(rowp + bj * 128) = w; } }
        } else {
            if (wc == 0 && fq < 2) {
#pragma unroll
                for (int ai = 0; ai < 2; ++ai)
#pragma unroll
                    for (int m = 0; m < 4; ++m) { float* rowp = FD + (size_t)(row0 + ai * 128 + m * 16) * 16 + fq * 8;
                        *(f32x4*)(rowp) = acc[ai][0][m][0] * DS; *(f32x4*)(rowp + 4) = acc[ai][0][m][1] * DS; }
            }
        }
    }
};
struct EpiOut {
    static constexpr bool PERM = false;
    const float* Xin; float* R;
    __device__ __forceinline__ void operator()(const f32x4 (&acc)[2][2][4][2], const Unit& u, int wr, int wc, int fr_, int fq_) const {
        int fr = fr_, fq = fq_; asm volatile("" : "+v"(fr), "+v"(fq));
        const int row0 = u.pm * 256 + wr * 64 + fr, col0 = u.pn * 256 + wc * 32 + fq * 4;
#pragma unroll
        for (int ai = 0; ai < 2; ++ai)
#pragma unroll
            for (int m = 0; m < 4; ++m) { const size_t off = (size_t)(row0 + ai * 128 + m * 16) * DM + col0;
#pragma unroll
                for (int bj = 0; bj < 2; ++bj)
#pragma unroll
                    for (int n = 0; n < 2; ++n) { const f32x4 x = *(const f32x4*)(Xin + off + bj * 128 + n * 16); *(f32x4*)(R + off + bj * 128 + n * 16) = x + acc[ai][bj][m][n]; } }
    }
};
template <bool WT> struct EpiGU_ {
    static constexpr bool PERM = true;
    bf16* H; const float* roww; const float* rstdv;
    __device__ __forceinline__ void operator()(const f32x4 (&acc)[2][2][4][2], const Unit& u, int wr, int wc, int fr, int fq) const {
        const int slot = u.pn >> 2;
        float w[2][4], rsd[2][4];
#pragma unroll
        for (int ai = 0; ai < 2; ++ai)
#pragma unroll
            for (int m = 0; m < 4; ++m) { const int grow = u.tb * 256 + ai * 128 + wr * 64 + m * 16 + fr; w[ai][m] = grow < u.cnt ? roww[((size_t)u.q * BCAP + grow) * 2 + slot] : 0.f; rsd[ai][m] = grow < u.cnt ? rstdv[(size_t)u.q * BCAP + grow] * MOE_GU_DESCALE : 0.f; }
        if constexpr (WT) {
#pragma unroll
            for (int ai = 0; ai < 2; ++ai)
#pragma unroll
                for (int bj = 0; bj < 2; ++bj) { unsigned o4[4];
#pragma unroll
                    for (int m = 0; m < 4; ++m) { const float rd = rsd[ai][m], w8 = w[ai][m] * MOE_H_SCALE; const f32x4 g = acc[ai][bj][m][0] * rd, up = acc[ai][bj][m][1] * rd;
                        const float h0 = __builtin_amdgcn_fmed3f(siluf_(g[0]) * up[0] * w8, -448.f, 448.f), h1 = __builtin_amdgcn_fmed3f(siluf_(g[1]) * up[1] * w8, -448.f, 448.f), h2 = __builtin_amdgcn_fmed3f(siluf_(g[2]) * up[2] * w8, -448.f, 448.f), h3 = __builtin_amdgcn_fmed3f(siluf_(g[3]) * up[3] * w8, -448.f, 448.f);
                        int o = 0; o = __builtin_amdgcn_cvt_pk_fp8_f32(h0, h1, o, false); o = __builtin_amdgcn_cvt_pk_fp8_f32(h2, h3, o, true); o4[m] = (unsigned)o; }
                    { auto r = __builtin_amdgcn_permlane16_swap(o4[0], o4[1], false, false); o4[0] = r[0]; o4[1] = r[1]; }
                    { auto r = __builtin_amdgcn_permlane16_swap(o4[2], o4[3], false, false); o4[2] = r[0]; o4[3] = r[1]; }
                    { auto r = __builtin_amdgcn_permlane32_swap(o4[0], o4[2], false, false); o4[0] = r[0]; o4[2] = r[1]; }
                    { auto r = __builtin_amdgcn_permlane32_swap(o4[1], o4[3], false, false); o4[1] = r[0]; o4[3] = r[1]; }
                    const int rloc = ai * 128 + wr * 64 + fq * 16 + fr;
                    const unsigned char* dp = (const unsigned char*)H + (size_t)(u.pm * 256 + rloc) * 1024 + slot * 512 + (u.pn & 3) * 128 + wc * 16 + bj * 64;
                    const v4u ov = (v4u){o4[0], o4[1], o4[2], o4[3]};
                    asm volatile("global_store_dwordx4 %0, %1, off sc1\n\ts_nop 1" :: "v"(dp), "v"(ov) : "memory"); }
            return;
        }
#pragma unroll
        for (int ai = 0; ai < 2; ++ai)
#pragma unroll
            for (int m = 0; m < 4; ++m) { const int rloc = ai * 128 + wr * 64 + m * 16 + fr; const float ww = w[ai][m], rd = rsd[ai][m];
                unsigned char* rowp = (unsigned char*)H + (size_t)(u.pm * 256 + rloc) * 1024 + slot * 512 + (u.pn & 3) * 128 + wc * 16 + fq * 4;
#pragma unroll
                for (int bj = 0; bj < 2; ++bj) { const f32x4 g = acc[ai][bj][m][0] * rd, up = acc[ai][bj][m][1] * rd; const float w8 = ww * MOE_H_SCALE;
                    const float h0 = __builtin_amdgcn_fmed3f(siluf_(g[0]) * up[0] * w8, -448.f, 448.f), h1 = __builtin_amdgcn_fmed3f(siluf_(g[1]) * up[1] * w8, -448.f, 448.f), h2 = __builtin_amdgcn_fmed3f(siluf_(g[2]) * up[2] * w8, -448.f, 448.f), h3 = __builtin_amdgcn_fmed3f(siluf_(g[3]) * up[3] * w8, -448.f, 448.f);
                    int o = 0; o = __builtin_amdgcn_cvt_pk_fp8_f32(h0, h1, o, false); o = __builtin_amdgcn_cvt_pk_fp8_f32(h2, h3, o, true);
                    if (WT) __hip_atomic_store((unsigned*)(rowp + bj * 64), (unsigned)o, RLX_AGENT); else *(int*)(rowp + bj * 64) = o; } }
    }
};
typedef EpiGU_<false> EpiGU;
struct EpiDown {
    static constexpr bool PERM = false;
    float* R; const int* perm; const LAS int* tokl;
    __device__ __forceinline__ void operator()(const f32x4 (&acc)[2][2][4][2], const Unit& u, int wr, int wc, int fr_, int fq) const {
        int fr = fr_; asm volatile("" : "+v"(fr));
        const int col0 = u.pn * 256 + wc * 32 + fq * 4;
#pragma unroll
        for (int ai = 0; ai < 2; ++ai)
#pragma unroll
            for (int m = 0; m < 4; ++m) { const int rloc = ai * 128 + wr * 64 + m * 16 + fr, grow = u.tb * 256 + rloc;
                if (grow < u.cnt) { const int tok = u.ord < TOK_UNITS ? tokl[u.ord * 256 + rloc] : perm[u.q * BCAP + grow]; float* rp = R + (size_t)tok * DM + col0;
#pragma unroll
                    for (int bj = 0; bj < 2; ++bj)
#pragma unroll
                        for (int n = 0; n < 2; ++n) { const f32x4 x = *(const f32x4*)(rp + bj * 128 + n * 16); *(f32x4*)(rp + bj * 128 + n * 16) = x + acc[ai][bj][m][n] * MOE_DN_DESCALE; } } }
    }
};

struct EpiF {
    static constexpr bool PERM = true;
    EpiGU_<true> gu; EpiDown dn; gu32* rdy;
    __device__ __forceinline__ void operator()(const f32x4 (&acc)[2][2][4][2], const Unit& u, int wr, int wc, int fr, int fq) const {
        if (u.kind == 0) gu(acc, u, wr, wc, fr, fq);
        else dn(acc, u, wr, wc, fr, fq);
    }
};

template <class Src>
__device__ __forceinline__ void transpose_item(const Src& src, bf16* WT, int Kd, LAS float* scr, int k0, int n0, int lane) {
    { f32x4 t4[8];
#pragma unroll
        for (int i = 0; i < 8; ++i) t4[i] = src.load4(k0 + 8 * i + (lane >> 3), n0 + 4 * (lane & 7));
#pragma unroll
        for (int i = 0; i < 8; ++i) { LAS float* d = scr + (8 * i + (lane >> 3)) * 33 + 4 * (lane & 7); d[0] = t4[i].x; d[1] = t4[i].y; d[2] = t4[i].z; d[3] = t4[i].w; } }
    LDS_WAIT(); asm volatile("" ::: "memory");
    const int c = lane & 7;
#pragma unroll
    for (int j = 0; j < 4; ++j) { const int n = (lane >> 3) + 8 * j; const LAS float* s = scr + (8 * c) * 33 + n;
        v4u o; o.x = pk2(s[0 * 33], s[1 * 33]); o.y = pk2(s[2 * 33], s[3 * 33]); o.z = pk2(s[4 * 33], s[5 * 33]); o.w = pk2(s[6 * 33], s[7 * 33]);
        *(v4u*)(WT + (size_t)(n0 + n) * Kd + k0 + 8 * c) = o; }
    LDS_WAIT(); asm volatile("" ::: "memory");
}
template <class Src>
__device__ __forceinline__ void transpose_item8(const Src& src, unsigned char* WT, int Kd, float scale, LAS float* scr, int k0, int n0, int lane) {
    { f32x4 t4[8];
#pragma unroll
        for (int i = 0; i < 8; ++i) t4[i] = src.load4(k0 + 8 * i + (lane >> 3), n0 + 4 * (lane & 7));
#pragma unroll
        for (int i = 0; i < 8; ++i) { LAS float* d = scr + (8 * i + (lane >> 3)) * 33 + 4 * (lane & 7); d[0] = t4[i].x; d[1] = t4[i].y; d[2] = t4[i].z; d[3] = t4[i].w; } }
    LDS_WAIT(); asm volatile("" ::: "memory");
    const int n = lane >> 1, kh = (lane & 1) * 32; const LAS float* sp = scr + kh * 33 + n;
    int w[8];
#pragma unroll
    for (int j = 0; j < 8; ++j) { int o = 0; o = __builtin_amdgcn_cvt_pk_fp8_f32(sp[(4 * j) * 33] * scale, sp[(4 * j + 1) * 33] * scale, o, false); o = __builtin_amdgcn_cvt_pk_fp8_f32(sp[(4 * j + 2) * 33] * scale, sp[(4 * j + 3) * 33] * scale, o, true); w[j] = o; }
    unsigned char* dp = WT + (size_t)(n0 + n) * Kd + k0 + kh;
    *(v4u*)dp = (v4u){(unsigned)w[0], (unsigned)w[1], (unsigned)w[2], (unsigned)w[3]}; *(v4u*)(dp + 16) = (v4u){(unsigned)w[4], (unsigned)w[5], (unsigned)w[6], (unsigned)w[7]};
    LDS_WAIT(); asm volatile("" ::: "memory");
}
__device__ __forceinline__ int win_src_col(int v) {
    if (v < 1024) { const int i = v >> 3, j = v & 7; return j < 4 ? 4 * i + j : 512 + 4 * i + (j - 4); }
    if (v < 3840) { const int o = v - 1024; return o < 1536 ? 1024 + o : 2568 + (o - 1536); }
    if (v < 3848) return 2560 + (v - 3840);
    if (v < 3856) return v;
    return -1;
}
struct SrcWin { const float* W; __device__ __forceinline__ f32x4 load4(int k, int v) const { const int c = win_src_col(v); return c < 0 ? (f32x4){0.f, 0.f, 0.f, 0.f} : *(const f32x4*)(W + (size_t)k * D_IN + c); } };
struct SrcPlain { const float* W; int N; __device__ __forceinline__ f32x4 load4(int k, int n) const { return *(const f32x4*)(W + (size_t)k * N + n); } };
struct SrcGU { const float* Wg; const float* Wu; __device__ __forceinline__ f32x4 load4(int k, int v) const { const int i = v >> 3; return (v & 4) ? *(const f32x4*)(Wu + (size_t)k * DEXP + 4 * i) : *(const f32x4*)(Wg + (size_t)k * DEXP + 4 * i); } };

template <bool FINAL>
__device__ __forceinline__ void norm_rows_t(Frame& F, const float* X, const float* gain, bf16* XN, unsigned char* XN8, float* out) {
    f32x4 g[4];
#pragma unroll
    for (int j = 0; j < 4; ++j) g[j] = *((const f32x4*)gain + F.lane + 64 * j);
    const int gw = F.vcu * 8 + F.wave, NGW = F.G * 8;
    f32x4 v[4], vn[4];
    if (gw < M) {
#pragma unroll
        for (int j = 0; j < 4; ++j) v[j] = *((const f32x4*)(X + (size_t)gw * DM) + F.lane + 64 * j); }
    for (int m = gw; m < M; m += NGW) {
        const int mn = m + NGW;
        if (mn < M) {
#pragma unroll
            for (int j = 0; j < 4; ++j) vn[j] = *((const f32x4*)(X + (size_t)mn * DM) + F.lane + 64 * j); }
        float s = 0.f;
#pragma unroll
        for (int j = 0; j < 4; ++j) s += (v[j].x * v[j].x + v[j].y * v[j].y) + (v[j].z * v[j].z + v[j].w * v[j].w);
        const float rstd = __builtin_amdgcn_rsqf(wave_sum(s) * (1.f / DM) + EPS);
        if (FINAL) { f32x4* o = (f32x4*)(out + (size_t)m * DM) + F.lane;
#pragma unroll
            for (int j = 0; j < 4; ++j) o[64 * j] = v[j] * rstd * g[j];
        } else { unsigned long long* o8 = (unsigned long long*)(XN + (size_t)m * DM) + F.lane;
#pragma unroll
            for (int j = 0; j < 4; ++j) { const f32x4 w = v[j] * rstd * g[j]; o8[64 * j] = (unsigned long long)pk2(w.x, w.y) | ((unsigned long long)pk2(w.z, w.w) << 32); }
            int* o4 = (int*)(XN8 + (size_t)m * DM) + F.lane;
#pragma unroll
            for (int j = 0; j < 4; ++j) { const f32x4 w = v[j] * (rstd * IN_X_SCALE) * g[j]; int o = 0; o = __builtin_amdgcn_cvt_pk_fp8_f32(w.x, w.y, o, false); o = __builtin_amdgcn_cvt_pk_fp8_f32(w.z, w.w, o, true); o4[64 * j] = o; } }
#pragma unroll
        for (int j = 0; j < 4; ++j) v[j] = vn[j];
    }
}
__device__ __forceinline__ void norm_rows_phase(Frame& F, const float* X, const float* gain, bf16* XN, unsigned char* XN8) { norm_rows_t<false>(F, X, gain, XN, XN8, nullptr); }
__device__ __forceinline__ void final_norm_phase(Frame& F, const float* X, const float* gain, float* out) { norm_rows_t<true>(F, X, gain, nullptr, nullptr, out); }
struct PItem { const float* src; int ld; bool zero, fp8; unsigned char* dst; int Kd; float scale; };
__device__ __forceinline__ void pitem_decode(Frame& F, unsigned char* ws, int it, PItem& p) {
    constexpr int I_IN = 16 * 64, I_OUT = 24 * 16, I_GU = 16 * 16, I_D = 8 * 16;
    constexpr int N_IN = DEPTH * I_IN, N_OUT = DEPTH * I_OUT, N_GU = DEPTH * NEXP * I_GU;
    const int nq4 = 4 * (F.lane & 15), kq = F.lane >> 4; int r = it; p.zero = false; p.scale = 1.f;
    if (r < N_IN) { const int l = r / I_IN, j = r % I_IN, k0 = (j / 64) * 64, n0 = (j % 64) * 64; const int c = win_src_col(n0 + nq4);
        p.zero = c < 0; p.ld = D_IN; p.src = inptr(F, 2) + (size_t)l * DM * D_IN + (size_t)(k0 + kq) * D_IN + (c < 0 ? 0 : c);
        if (n0 < NT8 * 256) { p.fp8 = true; p.Kd = DM; p.scale = IN_W_SCALE; p.dst = ws + WS_WIN8 + (size_t)l * NV_IN * DM + (size_t)n0 * DM + k0; return; }
        p.fp8 = false; p.Kd = DM; p.dst = ws + WS_WIN + ((size_t)l * NV_IN * DM + (size_t)n0 * DM + k0) * 2; return; }
    r -= N_IN;
    if (r < N_OUT) { const int l = r / I_OUT, j = r % I_OUT, k0 = (j / 16) * 64, n0 = (j % 16) * 64;
        p.ld = DM; p.src = inptr(F, 14) + (size_t)l * D_MIX * DM + (size_t)(k0 + kq) * DM + n0 + nq4;
        if (k0 >= 512 && k0 < 1024) { p.fp8 = true; p.Kd = 512; p.scale = OUT_W_SCALE; p.dst = ws + WS_WOUT8 + (size_t)l * DM * 512 + (size_t)n0 * 512 + (k0 - 512); return; }
        p.fp8 = false; p.Kd = D_MIX; p.dst = ws + WS_WOUT + ((size_t)l * DM * D_MIX + (size_t)n0 * D_MIX + k0) * 2; return; }
    r -= N_OUT;
    if (r < N_GU) { const int le = r / I_GU, j = r % I_GU, k0 = (j / 16) * 64, n0 = (j % 16) * 64; const int v = n0 + nq4;
        p.ld = DEXP; p.src = ((v & 4) ? inptr(F, 21) : inptr(F, 20)) + (size_t)le * DM * DEXP + (size_t)(k0 + kq) * DEXP + 4 * (v >> 3);
        p.fp8 = true; p.Kd = 1024; p.scale = MOE_WGU_SCALE; p.dst = ws + WS_WGU + (size_t)le * 1024 * 1024 + (size_t)n0 * 1024 + k0; return; }
    r -= N_GU;
    { const int le = r / I_D, j = r % I_D, k0 = (j / 16) * 64, n0 = (j % 16) * 64;
        p.ld = DM; p.src = inptr(F, 22) + (size_t)le * DEXP * DM + (size_t)(k0 + kq) * DM + n0 + nq4;
        p.fp8 = true; p.Kd = 512; p.scale = MOE_WD_SCALE; p.dst = ws + WS_WD + (size_t)le * 1024 * 512 + (size_t)n0 * 512 + k0; }
}
__device__ __forceinline__ void pitem_load(const PItem& p, f32x4 (&t4)[16]) {
#pragma unroll
    for (int i = 0; i < 16; ++i) { t4[i] = (f32x4){0.f, 0.f, 0.f, 0.f}; if (!p.zero) t4[i] = *(const f32x4*)(p.src + (size_t)(4 * i) * p.ld); }
}
__device__ __forceinline__ void convert_items(Frame& F, unsigned char* ws, LAS float* scr, const int gw, const int NGW, const int NITEMS) {
    const int lane = F.lane;
    PItem cur; f32x4 t4[16];
    if (gw < NITEMS) { pitem_decode(F, ws, gw, cur); pitem_load(cur, t4); }
    for (int it = gw; it < NITEMS; it += NGW) {
#pragma unroll
        for (int hf = 0; hf < 2; ++hf) {
            if (((lane >> 3) & 1) == hf) {
#pragma unroll
                for (int i = 0; i < 16; ++i) { LAS float* d = scr + (4 * i + (lane >> 4)) * 33 + 4 * (lane & 7); d[0] = t4[i].x; d[1] = t4[i].y; d[2] = t4[i].z; d[3] = t4[i].w; } }
            LDS_WAIT(); asm volatile("" ::: "memory");
            if (!cur.fp8) { const int c = lane & 7;
#pragma unroll
                for (int j = 0; j < 4; ++j) { const int n = (lane >> 3) + 8 * j; const LAS float* s = scr + (8 * c) * 33 + n;
                    v4u o; o.x = pk2(s[0 * 33], s[1 * 33]); o.y = pk2(s[2 * 33], s[3 * 33]); o.z = pk2(s[4 * 33], s[5 * 33]); o.w = pk2(s[6 * 33], s[7 * 33]);
                    *(v4u*)(cur.dst + ((size_t)(32 * hf + n) * cur.Kd + 8 * c) * 2) = o; }
            } else { const int n = lane >> 1, kh = (lane & 1) * 32; const LAS float* sp = scr + kh * 33 + n; const float scale = cur.scale; int w[8];
#pragma unroll
                for (int j = 0; j < 8; ++j) { int o = 0; o = __builtin_amdgcn_cvt_pk_fp8_f32(sp[(4 * j) * 33] * scale, sp[(4 * j + 1) * 33] * scale, o, false); o = __builtin_amdgcn_cvt_pk_fp8_f32(sp[(4 * j + 2) * 33] * scale, sp[(4 * j + 3) * 33] * scale, o, true); w[j] = o; }
                unsigned char* dp = cur.dst + (size_t)(32 * hf + n) * cur.Kd + kh;
                *(v4u*)dp = (v4u){(unsigned)w[0], (unsigned)w[1], (unsigned)w[2], (unsigned)w[3]}; *(v4u*)(dp + 16) = (v4u){(unsigned)w[4], (unsigned)w[5], (unsigned)w[6], (unsigned)w[7]}; }
            LDS_WAIT(); asm volatile("" ::: "memory");
        }
        if (it + NGW < NITEMS) { pitem_decode(F, ws, it + NGW, cur); pitem_load(cur, t4); }
    }
}
constexpr int PITEMS_DENSE = DEPTH * (16 * 64 + 24 * 16), PITEMS_MOE = DEPTH * NEXP * (16 * 16 + 8 * 16);
__device__ __forceinline__ void prologue_phase(Frame& F, unsigned char* ws) {
    convert_items(F, ws, (LAS float*)(F.lds + RING_OFF + F.wave * 16384), F.vcu * 8 + F.wave, F.G * 8, PITEMS_DENSE);
    norm_rows_phase(F, inptr(F, 0), inptr(F, 1), (bf16*)(ws + WS_XN), ws + WS_XN8);
}

struct MoeConvExtra {
    Frame* F; unsigned char* ws;
    static constexpr int NCH = PITEMS_MOE / 96, GRP = 5;
    __device__ __forceinline__ int total(int natt) const { return natt + NCH; }
    __device__ __forceinline__ bool map(int L, int& idx) const { if (L < NCH * GRP) { const int g = L / GRP, r = L % GRP; if (r == GRP - 1) { idx = g; return true; } idx = g * (GRP - 1) + r; return false; } idx = L - NCH; return false; }
    __device__ __forceinline__ void run(int chunk) const { Frame& f = *F; relaunder(f); const int base = PITEMS_DENSE + chunk * 96 + f.wave * 12;
        convert_items(f, ws, (LAS float*)(f.lds + RING_OFF + f.wave * 12288), base, 1, base + 12); }
};
struct NoExtra {
    __device__ __forceinline__ int total(int natt) const { return natt; }
    __device__ __forceinline__ bool map(int L, int& idx) const { idx = L; return false; }
    __device__ __forceinline__ void run(int) const {}
};
static_assert(PITEMS_MOE % 96 == 0, "expert weight items must split into whole chunks");

__device__ __forceinline__ float log_sigmoidf_(float x) { return fminf(x, 0.f) - log1pf(__expf(-fabsf(x))); }
constexpr float ATT_SKIP_NATS = 140.f;
__device__ __forceinline__ void fcum_unit(Frame& F, int bh, const float* FD, const float* fb, float* FC, int* TS) {
    relaunder(F);
    const int b = bh >> 3, h = bh & 7; const float bias = fb[h];
    LAS float* ws = (LAS float*)(F.lds);
    float v[8]; float run = 0.f;
#pragma unroll
    for (int i = 0; i < 8; ++i) { const int t = F.tid * 8 + i; run += log_sigmoidf_(FD[((size_t)b * SEQ + t) * 16 + h] + bias); v[i] = run; }
    float inc = run;
#pragma unroll
    for (int o = 1; o < 64; o <<= 1) { const float t = __builtin_bit_cast(float, __builtin_amdgcn_ds_bpermute(((F.lane - o) & 63) << 2, __builtin_bit_cast(int, inc))); if (F.lane >= o) inc += t; }
    __syncthreads();
    if (F.lane == 63) ws[F.wave] = inc;
    __syncthreads();
    float base = inc - run;
    for (int w = 0; w < F.wave; ++w) base += ws[w];
#pragma unroll
    for (int i = 0; i < 8; ++i) FC[(size_t)bh * SEQ + F.tid * 8 + i] = base + v[i];
    if ((F.tid & 7) == 7) ws[16 + (F.tid >> 3)] = base + v[7];
    __syncthreads();
    if (F.tid < 16) { const int qb = F.tid; const float cl = ws[16 + 4 * qb + 3]; int n = 0;
        for (int t = 0; t < 4 * qb; ++t) n += (cl - ws[16 + t] < -ATT_SKIP_NATS) ? 1 : 0;
        TS[bh * 16 + qb] = n & ~1; }
    __syncthreads();
}
__device__ __forceinline__ void conv_unit(Frame& F, int unit, const bf16* U, const float* dww, const float* dwb, const float* lng, const float* lnb, bf16* Y) {
    relaunder(F);
    const int b = unit >> 7, t0 = (unit & 127) * 32;
    LAS bf16* Gs = (LAS bf16*)(F.lds);
    LAS float* Ys = (LAS float*)(F.lds + 63488);
    __syncthreads();
    for (int c = F.tid; c < 62 * 64; c += 512) { const int r = c >> 6, ch = c & 63, t = t0 - 30 + r;
        v4u v = (v4u){0u, 0u, 0u, 0u}; if (t >= 0) v = *(const v4u*)(U + ((size_t)b * SEQ + t) * UP + UC_GLU + ch * 8);
        *(LAS v4u*)(Gs + r * 512 + ch * 8) = v; }
    __syncthreads();
    { const int ch = F.tid; float w[31];
#pragma unroll
        for (int k = 0; k < 31; ++k) { const GAS float* wp = (const GAS float*)dww + k * 512 + ch; asm volatile("" : "+v"(wp)); w[k] = *wp; }
        const float bias = dwb[ch];
        float g[62];
#pragma unroll
        for (int r = 0; r < 62; ++r) g[r] = bf2f(Gs[r * 512 + ch]);
#pragma unroll
        for (int tt = 0; tt < 32; ++tt) { float y = bias;
#pragma unroll
            for (int k = 0; k < 31; ++k) y += w[k] * g[tt + k];
            Ys[tt * 512 + ch] = y; } }
    __syncthreads();
    { const int ch0 = F.lane * 8;
        f32x4 ga = *(const f32x4*)(lng + ch0), gb = *(const f32x4*)(lng + ch0 + 4), ba = *(const f32x4*)(lnb + ch0), bb = *(const f32x4*)(lnb + ch0 + 4);
#pragma unroll
        for (int i = 0; i < 4; ++i) { const int tt = F.wave * 4 + i;
            f32x4 a = *(const LAS f32x4*)(Ys + tt * 512 + ch0), c = *(const LAS f32x4*)(Ys + tt * 512 + ch0 + 4);
            const float mu = wave_sum((a.x + a.y) + (a.z + a.w) + (c.x + c.y) + (c.z + c.w)) * (1.f / 512);
            a = a - mu; c = c - mu;
            const float var = wave_sum((a.x * a.x + a.y * a.y) + (a.z * a.z + a.w * a.w) + (c.x * c.x + c.y * c.y) + (c.z * c.z + c.w * c.w)) * (1.f / 512);
            const float rstd = __builtin_amdgcn_rsqf(var + EPS);
            a = a * rstd * ga + ba; c = c * rstd * gb + bb;
            v4u o; o.x = pk2(siluf_(a.x), siluf_(a.y)); o.y = pk2(siluf_(a.z), siluf_(a.w)); o.z = pk2(siluf_(c.x), siluf_(c.y)); o.w = pk2(siluf_(c.z), siluf_(c.w));
            *(v4u*)(Y + ((size_t)b * SEQ + t0 + tt) * YP + YC_CONV + ch0) = o; } }
}

__device__ __forceinline__ void conv_units(Frame& F, int first, int nunits, const bf16* U, const float* dww, const float* dwb, const float* lng, const float* lnb, bf16* Y) {
    relaunder(F);
    LAS bf16* Gs = (LAS bf16*)(F.lds);
    LAS float* Ys = (LAS float*)(F.lds + 63488);
    const int ch = F.tid;
    float w[31];
#pragma unroll
    for (int k = 0; k < 31; ++k) w[k] = dww[k * 512 + ch];
    const float bias = dwb[ch];
    const int ch0 = F.lane * 8;
    const f32x4 ga = *(const f32x4*)(lng + ch0), gb = *(const f32x4*)(lng + ch0 + 4), ba = *(const f32x4*)(lnb + ch0), bb = *(const f32x4*)(lnb + ch0 + 4);
    v4u pre[8];
#define CONV_LOAD(unit) do { const int b_ = (unit) >> 7, t0_ = ((unit) & 127) * 32; _Pragma("unroll") for (int j = 0; j < 8; ++j) { const int c = F.tid + 512 * j; const int r = c >> 6, cc = c & 63, t = t0_ - 30 + r; \
        pre[j] = (v4u){0u, 0u, 0u, 0u}; if (c < 62 * 64 && t >= 0) pre[j] = *(const v4u*)(U + ((size_t)b_ * SEQ + t) * UP + UC_GLU + cc * 8); } } while (0)
    if (first < nunits) CONV_LOAD(first);
    for (int unit = first; unit < nunits; unit += F.G) {
        const int b = unit >> 7, t0 = (unit & 127) * 32;
        __syncthreads();
#pragma unroll
        for (int j = 0; j < 8; ++j) { const int c = F.tid + 512 * j; if (c < 62 * 64) *(LAS v4u*)(Gs + (c >> 6) * 512 + (c & 63) * 8) = pre[j]; }
        __syncthreads();
        if (unit + F.G < nunits) CONV_LOAD(unit + F.G);
        { float g[62];
#pragma unroll
            for (int r = 0; r < 62; ++r) g[r] = bf2f(Gs[r * 512 + ch]);
#pragma unroll
            for (int tt = 0; tt < 32; ++tt) { float y = bias;
#pragma unroll
                for (int k = 0; k < 31; ++k) y += w[k] * g[tt + k];
                Ys[tt * 512 + ch] = y; } }
        __syncthreads();
#pragma unroll
        for (int i = 0; i < 4; ++i) { const int tt = F.wave * 4 + i;
            f32x4 a = *(const LAS f32x4*)(Ys + tt * 512 + ch0), c = *(const LAS f32x4*)(Ys + tt * 512 + ch0 + 4);
            const float mu = wave_sum((a.x + a.y) + (a.z + a.w) + (c.x + c.y) + (c.z + c.w)) * (1.f / 512);
            a = a - mu; c = c - mu;
            const float var = wave_sum((a.x * a.x + a.y * a.y) + (a.z * a.z + a.w * a.w) + (c.x * c.x + c.y * c.y) + (c.z * c.z + c.w * c.w)) * (1.f / 512);
            const float rstd = __builtin_amdgcn_rsqf(var + EPS);
            a = a * rstd * ga + ba; c = c * rstd * gb + bb;
            v4u o; o.x = pk2(siluf_(a.x), siluf_(a.y)); o.y = pk2(siluf_(a.z), siluf_(a.w)); o.z = pk2(siluf_(c.x), siluf_(c.y)); o.w = pk2(siluf_(c.z), siluf_(c.w));
            *(v4u*)(Y + ((size_t)b * SEQ + t0 + tt) * YP + YC_CONV + ch0) = o; }
    }
#undef CONV_LOAD
    __syncthreads();
}

__device__ __forceinline__ float softplusf_(float x) { return x > 20.f ? x : log1pf(__expf(x)); }
__device__ __forceinline__ void ssd_seq_unit(Frame& F, int unit, const bf16* U, const float* FD, bf16* Y, const float* cw, const float* cb, const float* dtbias, const float* Alog, const float* Dsk) {
    relaunder(F);
    const int b = unit >> 1, g = unit & 1, h = g * 4 + (F.wave >> 1), p = (F.wave & 1) * 32 + (F.lane >> 1), nh = F.lane & 1;
    LAS float* bc = (LAS float*)(F.lds) + F.wave * 128;
    const int chx = h * 64 + p, chB = 512 + g * 64 + F.lane, chC = 640 + g * 64 + F.lane;
    float wx[4], wB[4], wC[4];
#pragma unroll
    for (int k = 0; k < 4; ++k) { wx[k] = cw[k * 768 + chx]; wB[k] = cw[k * 768 + chB]; wC[k] = cw[k * 768 + chC]; }
    const float bx = cb[chx], bB = cb[chB], bC = cb[chC];
    const float dtb = dtbias[h], A = -__expf(Alog[h]), Dh = Dsk[h];
    float hs[32];
#pragma unroll
    for (int n = 0; n < 32; ++n) hs[n] = 0.f;
    float x1 = 0.f, x2 = 0.f, x3 = 0.f, B1 = 0.f, B2 = 0.f, B3 = 0.f, C1 = 0.f, C2_ = 0.f, C3 = 0.f;
    const bf16* Ub = U + (size_t)b * SEQ * UP; const float* FDb = FD + (size_t)b * SEQ * 16;
    float rx[4], rB[4], rC[4], rz[4], rd[4];
#pragma unroll
    for (int i = 0; i < 4; ++i) { const bf16* ur = Ub + (size_t)i * UP; rx[i] = bf2f(ur[UC_XS + chx]); rB[i] = bf2f(ur[UC_XS + chB]); rC[i] = bf2f(ur[UC_XS + chC]); rz[i] = bf2f(ur[UC_Z + chx]); rd[i] = FDb[(size_t)i * 16 + 8 + h]; }
#pragma unroll 1
    for (int tb = 0; tb < SEQ; tb += 4) {
        float nx[4], nB[4], nC[4], nz[4], nd[4];
#pragma unroll
        for (int i = 0; i < 4; ++i) { int t = tb + 4 + i; t = t < SEQ ? t : SEQ - 1; const bf16* ur = Ub + (size_t)t * UP;
            nx[i] = bf2f(ur[UC_XS + chx]); nB[i] = bf2f(ur[UC_XS + chB]); nC[i] = bf2f(ur[UC_XS + chC]); nz[i] = bf2f(ur[UC_Z + chx]); nd[i] = FDb[(size_t)t * 16 + 8 + h]; }
#pragma unroll
        for (int i = 0; i < 4; ++i) {
            const float x0 = rx[i], B0 = rB[i], C0 = rC[i];
            const float xc = siluf_(wx[0] * x3 + wx[1] * x2 + wx[2] * x1 + wx[3] * x0 + bx);
            const float Bv = siluf_(wB[0] * B3 + wB[1] * B2 + wB[2] * B1 + wB[3] * B0 + bB);
            const float Cv = siluf_(wC[0] * C3 + wC[1] * C2_ + wC[2] * C1 + wC[3] * C0 + bC);
            x3 = x2; x2 = x1; x1 = x0; B3 = B2; B2 = B1; B1 = B0; C3 = C2_; C2_ = C1; C1 = C0;
            const float dt = softplusf_(rd[i] + dtb), dA = __expf(dt * A), xdt = xc * dt;
            asm volatile("" ::: "memory");
            bc[F.lane] = Bv; bc[64 + F.lane] = Cv;
            LDS_WAIT(); asm volatile("" ::: "memory");
            float y = 0.f;
#pragma unroll
            for (int n4 = 0; n4 < 8; ++n4) { const f32x4 bb = *(const LAS f32x4*)(bc + nh * 32 + n4 * 4), cc = *(const LAS f32x4*)(bc + 64 + nh * 32 + n4 * 4);
                hs[n4 * 4 + 0] = hs[n4 * 4 + 0] * dA + bb.x * xdt; y += cc.x * hs[n4 * 4 + 0];
                hs[n4 * 4 + 1] = hs[n4 * 4 + 1] * dA + bb.y * xdt; y += cc.y * hs[n4 * 4 + 1];
                hs[n4 * 4 + 2] = hs[n4 * 4 + 2] * dA + bb.z * xdt; y += cc.z * hs[n4 * 4 + 2];
                hs[n4 * 4 + 3] = hs[n4 * 4 + 3] * dA + bb.w * xdt; y += cc.w * hs[n4 * 4 + 3]; }
            LDS_WAIT(); asm volatile("" ::: "memory");
            y += DPP_F(y, 0xB1);
            y += Dh * xc;
            const float yz = y * siluf_(rz[i]);
            if (nh == 0) Y[((size_t)b * SEQ + tb + i) * YP + YC_SSD + chx] = (bf16)f2bf(yz);
        }
#pragma unroll
        for (int i = 0; i < 4; ++i) { rx[i] = nx[i]; rB[i] = nB[i]; rC[i] = nC[i]; rz[i] = nz[i]; rd[i] = nd[i]; }
    }
}

constexpr size_t WS_CD = 163 * MiB;
constexpr size_t WS_HPB = 469 * MiB;
constexpr int SSD_XT = 0, SSD_B = 69632, SSD_C = 88064, SSD_DT = 106496, SSD_AC = 110592, SSD_ACT = 114688;
constexpr int XTS = 136, BCS = 72;
typedef float f32x16 __attribute__((ext_vector_type(16)));
__device__ __forceinline__ int crow16(int reg, int hi) { return (reg & 3) + 8 * (reg >> 2) + 4 * hi; }
#define MFMA32(a, b, c) __builtin_amdgcn_mfma_f32_32x32x16_bf16((a), (b), (c), 0, 0, 0)
__device__ __forceinline__ void ssd_scalars(Frame& F, int b, int c, const float* FD, const float* dtbias, const float* Alog) {
    LAS float* dts = (LAS float*)(F.lds + SSD_DT); LAS float* acs = (LAS float*)(F.lds + SSD_AC); LAS float* acT = (LAS float*)(F.lds + SSD_ACT);
    __syncthreads();
    { const int t = F.tid >> 2, hp = F.tid & 3; const size_t row = (size_t)b * SEQ + c * 128 + t;
#pragma unroll
        for (int k = 0; k < 2; ++k) { const int h = hp * 2 + k; const float dt = softplusf_(FD[row * 16 + 8 + h] + dtbias[h]); dts[t * 8 + h] = dt; acs[t * 8 + h] = -__expf(Alog[h]) * dt; } }
    __syncthreads();
    { const int h = F.wave; const float v0 = acs[(2 * F.lane) * 8 + h], v1 = acs[(2 * F.lane + 1) * 8 + h], sm = v0 + v1; float inc = sm;
#pragma unroll
        for (int o = 1; o < 64; o <<= 1) { const float tt = __builtin_bit_cast(float, __builtin_amdgcn_ds_bpermute(((F.lane - o) & 63) << 2, __builtin_bit_cast(int, inc))); if (F.lane >= o) inc += tt; }
        const float ex = inc - sm, a0 = ex + v0, a1 = ex + sm;
        acs[(2 * F.lane) * 8 + h] = a0; acs[(2 * F.lane + 1) * 8 + h] = a1; acT[h * 128 + 2 * F.lane] = a0; acT[h * 128 + 2 * F.lane + 1] = a1; }
    __syncthreads();
}
__device__ __forceinline__ float bf_of(const v4u& v, int j) { const unsigned w = j < 2 ? v.x : (j < 4 ? v.y : (j < 6 ? v.z : v.w)); return (j & 1) ? bfhi(w) : bflo(w); }
__device__ __forceinline__ void ssd_load_raw(v4u (&raw)[11], int b, int c, int tr, int ch768, const bf16* U) {
#pragma unroll
    for (int i = 0; i < 11; ++i) { const int tg = c * 128 + tr * 8 - 3 + i; raw[i] = (v4u){0u, 0u, 0u, 0u}; if (tg >= 0) raw[i] = *(const v4u*)(U + ((size_t)b * SEQ + tg) * UP + UC_XS + ch768); }
}
template <bool XS> __device__ __forceinline__ bool ssd_T_active(const Frame& F) { return XS || F.tid < 128; }
template <bool XS> __device__ __forceinline__ int ssd_T_tr(const Frame& F) { return XS ? (F.tid >> 5) : (F.tid >> 3); }
template <bool XS> __device__ __forceinline__ int ssd_T_ch(const Frame& F, int g) { const int cg = F.tid & (XS ? 31 : 7); return XS ? g * 256 + cg * 8 : 512 + g * 64 + cg * 8; }
template <bool XS>
__device__ __forceinline__ void ssd_stage_T(Frame& F, const v4u (&raw)[11], int g, const float* cw, const float* cb, bool passA) {
    if (!ssd_T_active<XS>(F)) return;
    const int ncg = XS ? 32 : 8;
    const int cg = F.tid & (ncg - 1), tr = ssd_T_tr<XS>(F);
    const int ch768 = ssd_T_ch<XS>(F, g);
    const int h = g * 4 + (cg >> 3);
    LAS float* dts = (LAS float*)(F.lds + SSD_DT); LAS float* acs = (LAS float*)(F.lds + SSD_AC);
    const float aend = acs[127 * 8 + h];
    float sc[8];
#pragma unroll
    for (int m = 0; m < 8; ++m) { const int tt = tr * 8 + m; sc[m] = 1.f; if (XS) { sc[m] = dts[tt * 8 + h]; if (passA) sc[m] *= __expf(aend - acs[tt * 8 + h]); } }
    LAS unsigned char* dst = F.lds + (XS ? SSD_XT : SSD_B);
#pragma unroll
    for (int j = 0; j < 8; ++j) {
        const float k0 = cw[ch768 + j], k1 = cw[768 + ch768 + j], k2 = cw[2 * 768 + ch768 + j], k3 = cw[3 * 768 + ch768 + j], bb = cb[ch768 + j];
        float xw[11]; unsigned o[4];
#pragma unroll
        for (int i = 0; i < 11; ++i) xw[i] = bf_of(raw[i], j);
#pragma unroll
        for (int m = 0; m < 8; m += 2) {
            const float v0 = siluf_(__builtin_fmaf(k0, xw[m], __builtin_fmaf(k1, xw[m + 1], __builtin_fmaf(k2, xw[m + 2], __builtin_fmaf(k3, xw[m + 3], bb))))) * sc[m];
            const float v1 = siluf_(__builtin_fmaf(k0, xw[m + 1], __builtin_fmaf(k1, xw[m + 2], __builtin_fmaf(k2, xw[m + 3], __builtin_fmaf(k3, xw[m + 4], bb))))) * sc[m + 1];
            o[m >> 1] = pk2(v0, v1); }
        *(LAS v4u*)(dst + ((cg * 8 + j) * XTS + tr * 8) * 2) = (v4u){o[0], o[1], o[2], o[3]};
    }
}
__device__ __forceinline__ int ssd_bc_ch(const Frame& F, int g) { return 512 + (F.tid >> 7) * 128 + g * 64 + (F.tid & 7) * 8; }
__device__ __forceinline__ void ssd_stage_bc(Frame& F, const v4u (&raw)[11], int g, const float* cw, const float* cb) {
    if (F.tid >= 256) return;
    const int which = F.tid >> 7, cg = F.tid & 7, tr = (F.tid >> 3) & 15;
    const int ch768 = ssd_bc_ch(F, g);
    LAS unsigned char* dst = F.lds + (which ? SSD_C : SSD_B);
    unsigned o[8][4];
#pragma unroll
    for (int j = 0; j < 8; j += 2) {
        const float k0 = cw[ch768 + j], k1 = cw[768 + ch768 + j], k2 = cw[2 * 768 + ch768 + j], k3 = cw[3 * 768 + ch768 + j], bb = cb[ch768 + j];
        const float q0 = cw[ch768 + j + 1], q1 = cw[768 + ch768 + j + 1], q2 = cw[2 * 768 + ch768 + j + 1], q3 = cw[3 * 768 + ch768 + j + 1], qb = cb[ch768 + j + 1];
        float xw[11], yw[11];
#pragma unroll
        for (int i = 0; i < 11; ++i) { xw[i] = bf_of(raw[i], j); yw[i] = bf_of(raw[i], j + 1); }
#pragma unroll
        for (int m = 0; m < 8; ++m) {
            const float v0 = siluf_(__builtin_fmaf(k0, xw[m], __builtin_fmaf(k1, xw[m + 1], __builtin_fmaf(k2, xw[m + 2], __builtin_fmaf(k3, xw[m + 3], bb)))));
            const float v1 = siluf_(__builtin_fmaf(q0, yw[m], __builtin_fmaf(q1, yw[m + 1], __builtin_fmaf(q2, yw[m + 2], __builtin_fmaf(q3, yw[m + 3], qb)))));
            o[m][j >> 1] = pk2(v0, v1); }
    }
#pragma unroll
    for (int m = 0; m < 8; ++m) *(LAS v4u*)(dst + ((tr * 8 + m) * BCS + cg * 8) * 2) = (v4u){o[m][0], o[m][1], o[m][2], o[m][3]};
}
__device__ __forceinline__ void ssd_passA_unit(Frame& F, int unit, const bf16* U, const float* FD, float* SST, float* CD, const float* cw, const float* cb, const float* dtbias, const float* Alog) {
    relaunder(F);
    const int b = unit >> 5, c = unit & 31;
    v4u rawx[11], rawb[11];
    ssd_load_raw(rawx, b, c, ssd_T_tr<true>(F), ssd_T_ch<true>(F, 0), U);
    if (ssd_T_active<false>(F)) ssd_load_raw(rawb, b, c, ssd_T_tr<false>(F), ssd_T_ch<false>(F, 0), U);
    ssd_scalars(F, b, c, FD, dtbias, Alog);
    if (F.tid < 8) CD[(b * 32 + c) * 8 + F.tid] = __expf(((LAS float*)(F.lds + SSD_AC))[127 * 8 + F.tid]);
#pragma unroll
    for (int g = 0; g < 2; ++g) {
        if (g) __syncthreads();
        ssd_stage_T<true>(F, rawx, g, cw, cb, true);
        ssd_stage_T<false>(F, rawb, g, cw, cb, true);
        __syncthreads();
        if (g == 0) { ssd_load_raw(rawx, b, c, ssd_T_tr<true>(F), ssd_T_ch<true>(F, 1), U); if (ssd_T_active<false>(F)) ssd_load_raw(rawb, b, c, ssd_T_tr<false>(F), ssd_T_ch<false>(F, 1), U); }
        const int hh = F.wave >> 1, pb = F.wave & 1, h = g * 4 + hh, r = F.lane & 31, hi = F.lane >> 5;
        const LAS unsigned char* ap = F.lds + SSD_XT + ((hh * 64 + pb * 32 + r) * XTS + hi * 8) * 2;
#pragma unroll
        for (int nb = 0; nb < 2; ++nb) {
            const LAS unsigned char* bp = F.lds + SSD_B + ((nb * 32 + r) * XTS + hi * 8) * 2;
            f32x16 acc = {0.f, 0.f, 0.f, 0.f, 0.f, 0.f, 0.f, 0.f, 0.f, 0.f, 0.f, 0.f, 0.f, 0.f, 0.f, 0.f};
#pragma unroll
            for (int ks = 0; ks < 8; ++ks) acc = MFMA32(*(const LAS bf16x8*)(ap + ks * 32), *(const LAS bf16x8*)(bp + ks * 32), acc);
            bf16* sp = (bf16*)SST + ((size_t)((b * 32 + c) * 8 + h) * 64) * 64 + nb * 32 + r;
#pragma unroll
            for (int reg = 0; reg < 16; ++reg) sp[(size_t)(pb * 32 + crow16(reg, hi)) * 64] = (bf16)f2bf(acc[reg]);
        }
    }
    __syncthreads();
}
__device__ __forceinline__ void ssd_scan_phase(Frame& F, const float* SST, const float* CD, bf16* HPB, unsigned* done) {
    for (int e = F.vcu * 512 + F.tid; e < NB * 8 * 2048; e += F.G * 512) {
        const int b = e >> 14, rem = (e & 16383) * 2, h = rem >> 12; f32x2 run = {0.f, 0.f};
        unsigned sw[32]; float d[32];
#pragma unroll
        for (int c = 0; c < 32; ++c) { const size_t idx = (size_t)((b * 32 + c) * 8) * 4096 + rem; d[c] = CD[(b * 32 + c) * 8 + h]; sw[c] = *(const unsigned*)((const bf16*)SST + idx); }
#pragma unroll
        for (int c = 0; c < 32; ++c) { const size_t idx = (size_t)((b * 32 + c) * 8) * 4096 + rem; __hip_atomic_store((unsigned*)(HPB + idx), pk2(run.x, run.y), RLX_AGENT);
            const f32x2 sv = {bflo(sw[c]), bfhi(sw[c])}; run = run * d[c] + sv; }
    }
    VM_WAIT(); __syncthreads();
    if (F.tid == 0) __hip_atomic_fetch_add(done, 1u, RLX_AGENT);
}
__device__ __forceinline__ void ssd_scan_wait(Frame& F, unsigned* done) {
    if (F.tid == 0) { unsigned sp = 0;
        while (__hip_atomic_load(done, RLX_AGENT) < (unsigned)F.G) { __builtin_amdgcn_s_sleep(2); if (++sp > (1u << 22)) { __hip_atomic_store((unsigned*)(F.ctl + CW_TMO), 0x5C00u, RLX_AGENT); break; } }
        __builtin_amdgcn_fence(__ATOMIC_ACQUIRE, "agent"); asm volatile("s_waitcnt vmcnt(0)" ::: "memory"); }
    __syncthreads();
}
__device__ __forceinline__ float ssq_f(unsigned long long t) { return (float)(unsigned)(t >> 32) + (float)(unsigned)t * 2.3283064365386963e-10f; }
__device__ __forceinline__ void ssd_passB_unit(Frame& F, int unit, const bf16* U, const float* FD, const bf16* HPB, bf16* Y, const float* cw, const float* cb, const float* dtbias, const float* Alog, const float* Dsk, const float* ng) {
    relaunder(F);
    const int b = unit >> 5, c = unit & 31;
    v4u rawx[11], rawbc[11];
    v2u held[2][4][2];
    LAS unsigned long long* ssq = (LAS unsigned long long*)(F.lds + TBL_OFF);
    if (F.tid < 128) ssq[F.tid] = 0ull;
    ssd_load_raw(rawx, b, c, ssd_T_tr<true>(F), ssd_T_ch<true>(F, 0), U);
    ssd_scalars(F, b, c, FD, dtbias, Alog);
    if (F.tid < 256) ssd_load_raw(rawbc, b, c, (F.tid >> 3) & 15, ssd_bc_ch(F, 0), U);
    LAS float* dts = (LAS float*)(F.lds + SSD_DT); LAS float* acs = (LAS float*)(F.lds + SSD_AC); LAS float* acT = (LAS float*)(F.lds + SSD_ACT);
#pragma unroll
    for (int g = 0; g < 2; ++g) {
        const int hh = F.wave >> 1, th = F.wave & 1, h = g * 4 + hh, r = F.lane & 31, hi = F.lane >> 5;
        const bf16* hp = HPB + (size_t)((b * 32 + c) * 8 + h) * 4096 + r * 64 + hi * 8;
        bf16x8 hq[2][4];
#pragma unroll
        for (int ks = 0; ks < 4; ++ks) { hq[0][ks] = *(const bf16x8*)(hp + ks * 16); hq[1][ks] = *(const bf16x8*)(hp + 32 * 64 + ks * 16); }
        if (g) { ssd_load_raw(rawx, b, c, ssd_T_tr<true>(F), ssd_T_ch<true>(F, 1), U); if (F.tid < 256) ssd_load_raw(rawbc, b, c, (F.tid >> 3) & 15, ssd_bc_ch(F, 1), U); __syncthreads(); }
        ssd_stage_T<true>(F, rawx, g, cw, cb, false);
        ssd_stage_bc(F, rawbc, g, cw, cb);
        __syncthreads();
        const float Dh = Dsk[h];
        const LAS unsigned char* xp = F.lds + SSD_XT + ((hh * 64 + r) * XTS + 4 * hi) * 2;
#pragma unroll
        for (int tq = 0; tq < 2; ++tq) {
            const int tbi = tq == 0 ? th : 3 - th, tl = 32 * tbi + r;
            v2u zq[4][2];
            { const size_t zrow = (size_t)b * SEQ + c * 128 + tl;
#pragma unroll
                for (int g4 = 0; g4 < 4; ++g4) { const int ch = h * 64 + 8 * g4 + 4 * hi; zq[g4][0] = *(const v2u*)(U + zrow * UP + UC_Z + ch); zq[g4][1] = *(const v2u*)(U + zrow * UP + UC_Z + ch + 32); } }
            const float at = acs[tl * 8 + h], dtt = dts[tl * 8 + h], et = __expf(at);
            bf16x8 cf[4];
#pragma unroll
            for (int ks = 0; ks < 4; ++ks) cf[ks] = *(const LAS bf16x8*)(F.lds + SSD_C + (tl * BCS + ks * 16 + hi * 8) * 2);
            f32x16 y0 = {0.f, 0.f, 0.f, 0.f, 0.f, 0.f, 0.f, 0.f, 0.f, 0.f, 0.f, 0.f, 0.f, 0.f, 0.f, 0.f}, y1 = y0;
#pragma unroll
            for (int ks = 0; ks < 4; ++ks) { y0 = MFMA32(hq[0][ks], cf[ks], y0); y1 = MFMA32(hq[1][ks], cf[ks], y1); }
#pragma unroll
            for (int reg = 0; reg < 16; ++reg) { y0[reg] *= et; y1[reg] *= et; }
#pragma unroll 1
            for (int sb = 0; sb <= tbi; ++sb) {
                f32x16 gt = {0.f, 0.f, 0.f, 0.f, 0.f, 0.f, 0.f, 0.f, 0.f, 0.f, 0.f, 0.f, 0.f, 0.f, 0.f, 0.f};
#pragma unroll
                for (int ks = 0; ks < 4; ++ks) gt = MFMA32(*(const LAS bf16x8*)(F.lds + SSD_B + ((32 * sb + r) * BCS + ks * 16 + hi * 8) * 2), cf[ks], gt);
                const bool diag = (sb == tbi);
#pragma unroll
                for (int g4 = 0; g4 < 4; ++g4) { const f32x4 as = *(const LAS f32x4*)(acT + h * 128 + 32 * sb + 8 * g4 + 4 * hi);
#pragma unroll
                    for (int j = 0; j < 4; ++j) { const int sl = 8 * g4 + 4 * hi + j; float v = gt[4 * g4 + j] * __expf(fminf(at - as[j], 0.f));
                        if (diag) { if (sl > r) v = 0.f; if (sl == r) v += Dh * __builtin_amdgcn_rcpf(dtt); }
                        gt[4 * g4 + j] = v; } }
#pragma unroll
                for (int ks2 = 0; ks2 < 2; ++ks2) {
                    const v4u xw = (v4u){pk2(gt[8 * ks2], gt[8 * ks2 + 1]), pk2(gt[8 * ks2 + 2], gt[8 * ks2 + 3]), pk2(gt[8 * ks2 + 4], gt[8 * ks2 + 5]), pk2(gt[8 * ks2 + 6], gt[8 * ks2 + 7])};
                    const bf16x8 xs = __builtin_bit_cast(bf16x8, xw);
                    const LAS unsigned char* xq = xp + (32 * sb + 16 * ks2) * 2;
                    const v2u l0 = *(const LAS v2u*)(xq), h0 = *(const LAS v2u*)(xq + 16), l1 = *(const LAS v2u*)(xq + 32 * XTS * 2), h1 = *(const LAS v2u*)(xq + 32 * XTS * 2 + 16);
                    y0 = MFMA32(__builtin_bit_cast(bf16x8, ((v4u){l0.x, l0.y, h0.x, h0.y})), xs, y0);
                    y1 = MFMA32(__builtin_bit_cast(bf16x8, ((v4u){l1.x, l1.y, h1.x, h1.y})), xs, y1);
                }
            }
            const size_t row = (size_t)b * SEQ + c * 128 + tl; float sq = 0.f;
#pragma unroll
            for (int g4 = 0; g4 < 4; ++g4) { const int ch = h * 64 + 8 * g4 + 4 * hi;
                const v2u z0 = zq[g4][0], z1 = zq[g4][1];
                const float a0 = y0[4 * g4] * siluf_(bflo(z0.x)), a1 = y0[4 * g4 + 1] * siluf_(bfhi(z0.x)), a2 = y0[4 * g4 + 2] * siluf_(bflo(z0.y)), a3 = y0[4 * g4 + 3] * siluf_(bfhi(z0.y));
                const float c0 = y1[4 * g4] * siluf_(bflo(z1.x)), c1 = y1[4 * g4 + 1] * siluf_(bfhi(z1.x)), c2 = y1[4 * g4 + 2] * siluf_(bflo(z1.y)), c3 = y1[4 * g4 + 3] * siluf_(bfhi(z1.y));
                const v2u o0 = (v2u){pk2(a0, a1), pk2(a2, a3)}, o1 = (v2u){pk2(c0, c1), pk2(c2, c3)};
                const float b0 = bflo(o0.x), b1 = bfhi(o0.x), b2 = bflo(o0.y), b3 = bfhi(o0.y), d0 = bflo(o1.x), d1 = bfhi(o1.x), d2 = bflo(o1.y), d3 = bfhi(o1.y);
                sq += (b0 * b0 + b1 * b1) + (b2 * b2 + b3 * b3) + (d0 * d0 + d1 * d1) + (d2 * d2 + d3 * d3);
                if (g == 0) { *(v2u*)(Y + row * YP + YC_SSD + ch) = o0; *(v2u*)(Y + row * YP + YC_SSD + ch + 32) = o1; } else { held[tq][g4][0] = o0; held[tq][g4][1] = o1; } }
            { const float sqc = fminf(sq, 8.0e6f); const unsigned qi = (unsigned)sqc, qf = (unsigned)((sqc - (float)qi) * 4294967296.f);
              __hip_atomic_fetch_add(ssq + tl, ((unsigned long long)qi << 32) | qf, __ATOMIC_RELAXED, __HIP_MEMORY_SCOPE_WORKGROUP); }
        }
    }
    VM_WAIT(); __syncthreads();
    { const int hh = F.wave >> 1, th = F.wave & 1, r = F.lane & 31, hi = F.lane >> 5;
        const f32x4 ga = *(const f32x4*)(ng + F.lane * 4);
        unsigned long long q0[16];
#pragma unroll
        for (int i = 0; i < 16; ++i) { unsigned long long* p = (unsigned long long*)(Y + ((size_t)b * SEQ + c * 128 + F.wave * 16 + i) * YP + YC_SSD) + F.lane; q0[i] = __hip_atomic_load(p, RLX_AGENT); }
#pragma unroll
        for (int tq = 0; tq < 2; ++tq) { const int tbi = tq == 0 ? th : 3 - th, tl = 32 * tbi + r; const float rstd = __builtin_amdgcn_rsqf(ssq_f(ssq[tl]) * (1.f / 512) + EPS);
            const size_t row = (size_t)b * SEQ + c * 128 + tl;
#pragma unroll
            for (int g4 = 0; g4 < 4; ++g4) { const int ch = (4 + hh) * 64 + 8 * g4 + 4 * hi;
#pragma unroll
                for (int pb = 0; pb < 2; ++pb) { const f32x4 gg = *(const f32x4*)(ng + ch + 32 * pb); const v2u hv = held[tq][g4][pb];
                    *(v2u*)(Y + row * YP + YC_SSD + ch + 32 * pb) = (v2u){pk2(bflo(hv.x) * rstd * gg.x, bfhi(hv.x) * rstd * gg.y), pk2(bflo(hv.y) * rstd * gg.z, bfhi(hv.y) * rstd * gg.w)}; } } }
#pragma unroll
        for (int i = 0; i < 16; ++i) { const int tl = F.wave * 16 + i; unsigned long long* p = (unsigned long long*)(Y + ((size_t)b * SEQ + c * 128 + tl) * YP + YC_SSD) + F.lane;
            const float rstd = __builtin_amdgcn_rsqf(ssq_f(ssq[tl]) * (1.f / 512) + EPS);
            const float a0 = bflo((unsigned)q0[i]), a1 = bfhi((unsigned)q0[i]), a2 = bflo((unsigned)(q0[i] >> 32)), a3 = bfhi((unsigned)(q0[i] >> 32));
            p[0] = (unsigned long long)pk2(a0 * rstd * ga.x, a1 * rstd * ga.y) | ((unsigned long long)pk2(a2 * rstd * ga.z, a3 * rstd * ga.w) << 32); } }
    __syncthreads();
}

__device__ __forceinline__ void ssd_norm_phase(Frame& F, bf16* Y, const float* ng) {
    const int gw = F.vcu * 8 + F.wave, NGW = F.G * 8, ch0 = F.lane * 8;
    const f32x4 ga = *(const f32x4*)(ng + ch0), gb = *(const f32x4*)(ng + ch0 + 4);
    for (int m = gw; m < M; m += NGW) { bf16* p = Y + (size_t)m * YP + YC_SSD + ch0; const v4u v = *(const v4u*)p;
        const float a0 = bflo(v.x), a1 = bfhi(v.x), a2 = bflo(v.y), a3 = bfhi(v.y), a4 = bflo(v.z), a5 = bfhi(v.z), a6 = bflo(v.w), a7 = bfhi(v.w);
        const float ss = wave_sum((a0 * a0 + a1 * a1) + (a2 * a2 + a3 * a3) + (a4 * a4 + a5 * a5) + (a6 * a6 + a7 * a7));
        const float rstd = __builtin_amdgcn_rsqf(ss * (1.f / 512) + EPS);
        v4u o; o.x = pk2(a0 * rstd * ga.x, a1 * rstd * ga.y); o.y = pk2(a2 * rstd * ga.z, a3 * rstd * ga.w); o.z = pk2(a4 * rstd * gb.x, a5 * rstd * gb.y); o.w = pk2(a6 * rstd * gb.z, a7 * rstd * gb.w);
        *(v4u*)p = o; }
}

__device__ __forceinline__ void attn_naive_phase(Frame& F, const bf16* U, const float* FC, bf16* Y) {
    LAS float* Ks = (LAS float*)(F.lds); LAS float* Vs = Ks + 4096; LAS float* Cs = Vs + 4096;
    const int hf = F.tid & 1;
    for (int i = 0; ; ++i) {
        const int L = i * F.G + F.vcu; if (L >= 1024) break;
        relaunder(F);
        const int bh = (L & 255) >> 2, s = L & 3, jj = L >> 8, qb = jj == 0 ? s : (jj == 1 ? 7 - s : (jj == 2 ? 8 + s : 15 - s));
        const int b = bh >> 3, h = bh & 7, q = qb * 256 + (F.tid >> 1);
        float qv[32], o[32];
        { const v4u* qp = (const v4u*)(U + ((size_t)b * SEQ + q) * UP + UC_Q + h * 64 + hf * 32);
#pragma unroll
            for (int j = 0; j < 4; ++j) { const v4u w = qp[j]; qv[8 * j + 0] = bflo(w.x); qv[8 * j + 1] = bfhi(w.x); qv[8 * j + 2] = bflo(w.y); qv[8 * j + 3] = bfhi(w.y); qv[8 * j + 4] = bflo(w.z); qv[8 * j + 5] = bfhi(w.z); qv[8 * j + 6] = bflo(w.w); qv[8 * j + 7] = bfhi(w.w); } }
#pragma unroll
        for (int d = 0; d < 32; ++d) o[d] = 0.f;
        const float cq = FC[(size_t)bh * SEQ + q];
        float mrun = -1e30f, lrun = 0.f;
        const int nkt = (qb * 256 + 256) / 64;
#pragma unroll 1
        for (int kt = 0; kt < nkt; ++kt) {
            __syncthreads();
            { const int key = F.tid >> 3, d0 = (F.tid & 7) * 8; const size_t row = (size_t)b * SEQ + kt * 64 + key;
                const v4u kw = *(const v4u*)(U + row * UP + UC_K + h * 64 + d0), vw = *(const v4u*)(U + row * UP + UC_V + h * 64 + d0);
                LAS float* kd = Ks + key * 64 + d0; LAS float* vd = Vs + key * 64 + d0;
                *(LAS f32x4*)kd = (f32x4){bflo(kw.x), bfhi(kw.x), bflo(kw.y), bfhi(kw.y)}; *(LAS f32x4*)(kd + 4) = (f32x4){bflo(kw.z), bfhi(kw.z), bflo(kw.w), bfhi(kw.w)};
                *(LAS f32x4*)vd = (f32x4){bflo(vw.x), bfhi(vw.x), bflo(vw.y), bfhi(vw.y)}; *(LAS f32x4*)(vd + 4) = (f32x4){bflo(vw.z), bfhi(vw.z), bflo(vw.w), bfhi(vw.w)};
                if (F.tid < 64) Cs[F.tid] = FC[(size_t)bh * SEQ + kt * 64 + F.tid]; }
            __syncthreads();
#pragma unroll 1
            for (int jc = 0; jc < 16; ++jc) {
                float sc[4]; float cm = -1e30f;
#pragma unroll
                for (int j = 0; j < 4; ++j) { const int key = jc * 4 + j; float d = 0.f;
#pragma unroll
                    for (int dd = 0; dd < 32; dd += 4) { const f32x4 kk = *(const LAS f32x4*)(Ks + key * 64 + hf * 32 + dd); d += qv[dd] * kk.x + qv[dd + 1] * kk.y + qv[dd + 2] * kk.z + qv[dd + 3] * kk.w; }
                    d += DPP_F(d, 0xB1);
                    d += (cq - Cs[key]) * LOG2E; if (kt * 64 + key > q) d = -1e30f; sc[j] = d; cm = fmaxf(cm, d); }
                asm volatile("" ::: "memory");
                const float mn = fmaxf(mrun, cm), f = __builtin_amdgcn_exp2f(mrun - mn); lrun *= f; mrun = mn;
#pragma unroll
                for (int d = 0; d < 32; ++d) o[d] *= f;
#pragma unroll
                for (int j = 0; j < 4; ++j) { const int key = jc * 4 + j; const float pj = __builtin_amdgcn_exp2f(sc[j] - mrun); lrun += pj;
#pragma unroll
                    for (int dd = 0; dd < 32; dd += 4) { const f32x4 vv = *(const LAS f32x4*)(Vs + key * 64 + hf * 32 + dd); o[dd] += pj * vv.x; o[dd + 1] += pj * vv.y; o[dd + 2] += pj * vv.z; o[dd + 3] += pj * vv.w; } }
                asm volatile("" ::: "memory");
            }
        }
        const float rl = 1.0f / lrun;
        v4u* op = (v4u*)(Y + ((size_t)b * SEQ + q) * YP + YC_ATT + h * 64 + hf * 32);
#pragma unroll
        for (int j = 0; j < 4; ++j) { v4u w; w.x = pk2(o[8 * j] * rl, o[8 * j + 1] * rl); w.y = pk2(o[8 * j + 2] * rl, o[8 * j + 3] * rl); w.z = pk2(o[8 * j + 4] * rl, o[8 * j + 5] * rl); w.w = pk2(o[8 * j + 6] * rl, o[8 * j + 7] * rl); op[j] = w; }
    }
    __syncthreads();
}

namespace attn_body {
using bf16=__hip_bfloat16;
using bf16x8=__attribute__((ext_vector_type(8)))short;
using s16x4=__attribute__((ext_vector_type(4)))short;
using f32x16=__attribute__((ext_vector_type(16)))float;
using u32x4=__attribute__((ext_vector_type(4)))unsigned;
constexpr int BATCH=8,NHEAD=8,SEQ=4096,D=64,DM=3328,OPITCH=1536;
constexpr int NW=8,QBLK=32,QB=QBLK*NW,KVBLK=64,NQB=SEQ/QB;
constexpr int ATTN_PITCH=DM, ATTN_UNIT_ROWS=QB;
constexpr int LDS_BIAS=86016;
__device__ __forceinline__ int crow(int r,int hi){return (r&3)+8*(r>>2)+4*hi;}
#define SBAR() __builtin_amdgcn_sched_barrier(0)
__device__ __forceinline__ void cmask(f32x16&p0,f32x16&p1,int jb,int qrel,int hi){
  const float NEG=-INFINITY; int kb=64*jb+4*hi;
  #pragma unroll
  for(int r=0;r<16;++r){int kv=kb+(r&3)+8*(r>>2); if(kv>qrel)p0[r]=NEG; if(kv+32>qrel)p1[r]=NEG;}
}

constexpr int NSLOT=3, SLOTB=8192;
constexpr int LDS_K=0, LDS_V=NSLOT*SLOTB, LDS_WS=2*NSLOT*SLOTB, LDS_OST=LDS_WS+NW*64*4, LDS_BYTES=LDS_OST+NW*4096;
constexpr float C2A=0.125f*1.4426950408889634f;
__device__ __forceinline__ void glds16(const void*gsrc,unsigned lds_dst){unsigned keep;
  asm volatile("s_mov_b32 %0, m0\n\ts_mov_b32 m0, %2\n\ts_nop 0\n\tglobal_load_lds_dwordx4 %1, off\n\ts_mov_b32 m0, %0":"=&s"(keep):"v"(gsrc),"s"(lds_dst):"memory");}
__device__ __forceinline__ float max3f(float a,float b,float c){float r;asm("v_max3_f32 %0, %1, %2, %3":"=v"(r):"v"(a),"v"(b),"v"(c));return r;}
__device__ __forceinline__ float max2f(float a,float b){float r;asm("v_max_f32_e32 %0, %1, %2":"=v"(r):"v"(a),"v"(b));return r;}
__device__ __forceinline__ float fadd_s(float a,float b){float r;asm("v_add_f32_e32 %0, %1, %2":"=v"(r):"v"(a),"v"(b));return r;}
__device__ __forceinline__ float fsub_s(float a,float b){float r;asm("v_sub_f32_e32 %0, %1, %2":"=v"(r):"v"(a),"v"(b));return r;}
typedef float f32x2_t __attribute__((ext_vector_type(2))); typedef __bf16 bf16x2_t __attribute__((ext_vector_type(2)));
__device__ __forceinline__ unsigned cvtpk_s(float lo,float hi){f32x2_t v={lo,hi};bf16x2_t b=__builtin_convertvector(v,bf16x2_t);return __builtin_bit_cast(unsigned,b);}
#define WAIT_BAR(N) asm volatile("s_waitcnt vmcnt(" #N ") lgkmcnt(0)\n\ts_barrier":::"memory")

__device__ __forceinline__ void qkt(f32x16&p0,f32x16&p1,const char*Kslot,const bf16x8*qr,int r32,int hi){ const f32x16 zc=f32x16{};
  const char*kb=Kslot+hi*1024+r32*16;
  #pragma unroll
  for(int d0=0;d0<4;++d0){
    const bf16x8 b0=*reinterpret_cast<const bf16x8*>(kb+d0*2048);
    const bf16x8 b1=*reinterpret_cast<const bf16x8*>(kb+d0*2048+512);
    if(d0==0){p0=__builtin_amdgcn_mfma_f32_32x32x16_bf16(b0,qr[0],zc,0,0,0);p1=__builtin_amdgcn_mfma_f32_32x32x16_bf16(b1,qr[0],zc,0,0,0);}
    else{p0=__builtin_amdgcn_mfma_f32_32x32x16_bf16(b0,qr[d0],p0,0,0,0);p1=__builtin_amdgcn_mfma_f32_32x32x16_bf16(b1,qr[d0],p1,0,0,0);}}
}
typedef __attribute__((address_space(3))) const char* lds_cptr;
typedef short v4i16_t __attribute__((ext_vector_type(4)));
__device__ __forceinline__ void kload8(bf16x8*kf,lds_cptr kp){
  kf[0]=*(const __attribute__((address_space(3))) bf16x8*)(kp);      kf[1]=*(const __attribute__((address_space(3))) bf16x8*)(kp+512);
  kf[2]=*(const __attribute__((address_space(3))) bf16x8*)(kp+2048); kf[3]=*(const __attribute__((address_space(3))) bf16x8*)(kp+2560);
  kf[4]=*(const __attribute__((address_space(3))) bf16x8*)(kp+4096); kf[5]=*(const __attribute__((address_space(3))) bf16x8*)(kp+4608);
  kf[6]=*(const __attribute__((address_space(3))) bf16x8*)(kp+6144); kf[7]=*(const __attribute__((address_space(3))) bf16x8*)(kp+6656);
}
__device__ __forceinline__ void kload2(bf16x8*kf,lds_cptr kp,int j){ kf[2*j]=*(const __attribute__((address_space(3))) bf16x8*)(kp+j*2048); kf[2*j+1]=*(const __attribute__((address_space(3))) bf16x8*)(kp+j*2048+512); }
__device__ __forceinline__ s16x4 vtr(lds_cptr p){ return __builtin_bit_cast(s16x4,__builtin_amdgcn_ds_read_tr16_b64_v4i16((__attribute__((address_space(3))) v4i16_t*)p)); }
__device__ __forceinline__ float rowmax(const f32x16&p0,const f32x16&p1){
  float a=max3f(p0[0],p0[1],p1[0]),b=max3f(p0[2],p0[3],p1[1]);a=max3f(a,p1[2],p1[3]);
  #pragma unroll
  for(int r=4;r<16;r+=4){a=max3f(a,p0[r],p0[r+1]);b=max3f(b,p0[r+2],p0[r+3]);a=max3f(a,p1[r],p1[r+1]);b=max3f(b,p1[r+2],p1[r+3]);}
  const float m=max2f(a,b);
  auto rr=__builtin_amdgcn_permlane32_swap(__float_as_uint(m),__float_as_uint(m),false,false);
  return max2f(__uint_as_float(rr[0]),__uint_as_float(rr[1]));
}
__device__ __forceinline__ void pv(f32x16*o,int vb,bf16x8 pa0,bf16x8 pa1,bf16x8 pa2,bf16x8 pa3){
  #pragma unroll
  for(int d0=0;d0<2;++d0){s16x4 lo[4],hi[4];
    #pragma unroll
    for(int ks=0;ks<4;++ks){
      asm volatile("ds_read_b64_tr_b16 %0,%1 offset:%c2":"=&v"(lo[ks]):"v"(vb),"i"(d0*4096+ks*1024):"memory");
      asm volatile("ds_read_b64_tr_b16 %0,%1 offset:%c2":"=&v"(hi[ks]):"v"(vb),"i"(d0*4096+ks*1024+512):"memory");}
    asm volatile("s_waitcnt lgkmcnt(0)":::"memory");SBAR();
    #define PK(k) (bf16x8){lo[k][0],lo[k][1],lo[k][2],lo[k][3],hi[k][0],hi[k][1],hi[k][2],hi[k][3]}
    o[d0]=__builtin_amdgcn_mfma_f32_32x32x16_bf16(pa0,PK(0),o[d0],0,0,0);
    o[d0]=__builtin_amdgcn_mfma_f32_32x32x16_bf16(pa1,PK(1),o[d0],0,0,0);
    o[d0]=__builtin_amdgcn_mfma_f32_32x32x16_bf16(pa2,PK(2),o[d0],0,0,0);
    o[d0]=__builtin_amdgcn_mfma_f32_32x32x16_bf16(pa3,PK(3),o[d0],0,0,0);
    #undef PK
  }
}

#ifndef ATTN_STORE16
#define ATTN_STORE16(p,v) (*(u32x4*)(p)=(v))
#endif
template<int THRL> __device__ __forceinline__ void attn_unit(int tid_in,int b,int h,int qb,int t0,const bf16*Q,const bf16*__restrict__ K,const bf16*__restrict__ V,bf16*O,const float*__restrict__ FCb,char*shm){
  int tid_=tid_in; asm volatile("":"+v"(tid_));
  const int tid=tid_,lane=tid&63,r32=lane&31,hi=lane>>5; const int wid=__builtin_amdgcn_readfirstlane(tid>>6);
  const long rowbase=(long)b*SEQ; const int q0=qb*QB;
  const bf16*Qw=Q+(rowbase+q0+wid*QBLK)*DM+h*D;
  const bf16*Kh=K+(rowbase+(long)t0*KVBLK)*DM+h*D,*Vh=V+(rowbase+(long)t0*KVBLK)*DM+h*D;
  const unsigned lds0=(unsigned)(uintptr_t)shm;
  const lds_cptr shm3=(lds_cptr)shm;
  float*wsf=(float*)(shm+LDS_WS)+wid*64;
  const bf16*ksrc=Kh+(long)lane*DM+wid*8;
  const bf16*vsrc=Vh+(long)(16*(wid&3)+(lane>>2))*DM+(wid>>2)*32+(lane&3)*8;
  const unsigned kdst=lds0+LDS_K+wid*1024, vdst=lds0+LDS_V+wid*1024;
  #define DMA_K(t,slot) glds16(ksrc+(long)(t)*KVBLK*DM,(unsigned)__builtin_amdgcn_readfirstlane(kdst+(slot)))
  #define DMA_V(t,slot) glds16(vsrc+(long)(t)*KVBLK*DM,(unsigned)__builtin_amdgcn_readfirstlane(vdst+(slot)))
  const int vb0=(int)(lds0+LDS_V)+((lane>>4)&1)*32+(lane&3)*8+(4*hi+((lane&15)>>2))*64;
  const char*Kbase=shm+LDS_K; bf16x8 kf[8];
  const lds_cptr kp0=shm3+LDS_K+hi*1024+r32*16; const lds_cptr vp0=shm3+LDS_V+((lane>>4)&1)*32+(lane&3)*8+(4*hi+((lane&15)>>2))*64;
  const int NT=(q0+QB)/KVBLK-t0;
  DMA_K(0,0);DMA_V(0,0);DMA_K(1,SLOTB);
  float mrow;
  { typedef float f4_t __attribute__((ext_vector_type(4)));
    const float cref=FCb[q0]; const int nk=q0+QB; mrow=(cref-FCb[q0+wid*QBLK+r32])*1.4426950408889634f;
    __attribute__((address_space(3))) float*bl=(__attribute__((address_space(3))) float*)(shm3+LDS_BIAS);
    for(int k=t0*64+tid*4;k<nk;k+=2048){ const f4_t c=*reinterpret_cast<const f4_t*>(FCb+k); f4_t o; o.x=(cref-c.x)*1.4426950408889634f; o.y=(cref-c.y)*1.4426950408889634f; o.z=(cref-c.z)*1.4426950408889634f; o.w=(cref-c.w)*1.4426950408889634f;
      *reinterpret_cast<__attribute__((address_space(3))) f4_t*>(bl+k)=o; }
    asm volatile("s_waitcnt vmcnt(0) lgkmcnt(0)":::"memory"); }
  bf16x8 qr[4];
  #pragma unroll
  for(int d0=0;d0<4;++d0)qr[d0]=*reinterpret_cast<const bf16x8*>(&Qw[(long)r32*DM+d0*16+hi*8]);
  float mhat=FOX_FIXED_REF?mrow:0.f,l_reg=0.f;f32x16 o[2];o[0]=f32x16{};o[1]=f32x16{};const f32x16 zc=f32x16{};
  const int qrel=wid*QBLK+r32;
  #define CMASK(P0,P1,t) do{int jb_=(t)-(NT-4); if(jb_>=0)cmask(P0,P1,jb_,qrel,hi);}while(0)
  typedef float f4b_t __attribute__((ext_vector_type(4)));
  const __attribute__((address_space(3))) float* blp=(const __attribute__((address_space(3))) float*)(shm3+LDS_BIAS)+4*hi+t0*64;
  #define BIAS(P0,P1,t) do{ const __attribute__((address_space(3))) float* bp_=blp+(t)*64; const float nm_=-mhat; \
    _Pragma("unroll") for(int g_=0;g_<4;++g_){ const f4b_t b0_=*reinterpret_cast<const __attribute__((address_space(3))) f4b_t*>(bp_+8*g_); const f4b_t b1_=*reinterpret_cast<const __attribute__((address_space(3))) f4b_t*>(bp_+32+8*g_); \
      P0[4*g_]+=b0_.x+nm_;P0[4*g_+1]+=b0_.y+nm_;P0[4*g_+2]+=b0_.z+nm_;P0[4*g_+3]+=b0_.w+nm_; P1[4*g_]+=b1_.x+nm_;P1[4*g_+1]+=b1_.y+nm_;P1[4*g_+2]+=b1_.z+nm_;P1[4*g_+3]+=b1_.w+nm_; } }while(0)
  #define BLOAD(P0,P1,tt) do{ const __attribute__((address_space(3))) float* bp_=blp+(tt)*64; \
    _Pragma("unroll") for(int g_=0;g_<4;++g_){ const f4b_t b0_=*reinterpret_cast<const __attribute__((address_space(3))) f4b_t*>(bp_+8*g_); const f4b_t b1_=*reinterpret_cast<const __attribute__((address_space(3))) f4b_t*>(bp_+32+8*g_); \
      P0[4*g_]=b0_.x;P0[4*g_+1]=b0_.y;P0[4*g_+2]=b0_.z;P0[4*g_+3]=b0_.w; P1[4*g_]=b1_.x;P1[4*g_+1]=b1_.y;P1[4*g_+2]=b1_.z;P1[4*g_+3]=b1_.w; } }while(0)
  #define BSUB(P0,P1) do{ _Pragma("unroll") for(int r=0;r<16;++r){P0[r]-=mhat;P1[r]-=mhat;} }while(0)
  bool resc=false;
#if FOX_FIXED_REF
  #define START(P0,P1) do{ _Pragma("unroll") for(int r=0;r<16;++r)P0[r]=__builtin_amdgcn_exp2f(P0[r]); }while(0)
  #define REFTRACK(C0,C1) do{}while(0)
#else
  #define START(P0,P1) do{ const float rm=rowmax(P0,P1); resc=false; \
    { const float dl=rm; mhat=fadd_s(mhat,dl); \
      _Pragma("unroll") for(int r=0;r<16;++r){P0[r]=fsub_s(P0[r],dl);P1[r]=fsub_s(P1[r],dl);} \
      } \
    _Pragma("unroll") for(int r=0;r<16;++r)P0[r]=__builtin_amdgcn_exp2f(P0[r]); }while(0)
  #define REFTRACK(C0,C1) do{ float a=MX3(C0[0],C0[1],C1[0]),b=MX3(C0[2],C0[3],C1[1]); a=MX3(a,C1[2],C1[3]); \
      _Pragma("unroll") for(int r=4;r<16;r+=4){a=MX3(a,C0[r],C0[r+1]);b=MX3(b,C0[r+2],C0[r+3]);a=MX3(a,C1[r],C1[r+1]);b=MX3(b,C1[r+2],C1[r+3]);} \
      float rm=__builtin_fmaxf(a,b); { auto rr=__builtin_amdgcn_permlane32_swap(__float_as_uint(rm),__float_as_uint(rm),false,false); rm=__builtin_fmaxf(__uint_as_float(rr[0]),__uint_as_float(rr[1])); } \
      resc=false; \
      if(__builtin_expect(__any(rm>(float)THRL),0)){ const float dl=__builtin_fmaxf(rm,0.f); mhat+=dl; \
        _Pragma("unroll") for(int r=0;r<16;++r){C0[r]-=dl;C1[r]-=dl;} \
        const float f=__builtin_amdgcn_exp2f(-dl); l_reg*=f; if(hi==0)wsf[r32]=f; resc=true; } }while(0)
#endif
#if FOX_FIXED_REF
  #define RESC() do{}while(0)
#else
  #define RESC() do{ if(resc){ asm volatile("s_waitcnt lgkmcnt(0)":::"memory"); \
      _Pragma("unroll") for(int d_=0;d_<2;++d_) _Pragma("unroll") for(int r=0;r<16;++r)o[d_][r]*=wsf[crow(r,hi)]; } }while(0)
#endif
  f32x16 pA0,pA1,pB0,pB1;
  int sl_prev=0,sl_cur=0,sl_next=SLOTB;
  #define ROT() do{sl_prev=sl_cur;sl_cur=sl_next;sl_next=(sl_next==(NSLOT-1)*SLOTB)?0:sl_next+SLOTB;}while(0)
  DMA_K(2,2*SLOTB);
  WAIT_BAR(3);
  qkt(pA0,pA1,Kbase,qr,r32,hi);asm volatile("s_nop 15\n\ts_nop 7":"+v"(pA0),"+v"(pA1));BIAS(pA0,pA1,0);CMASK(pA0,pA1,0);
  START(pA0,pA1);
  _Pragma("unroll") for(int r=0;r<16;++r)pA1[r]=__builtin_amdgcn_exp2f(pA1[r]);
  WAIT_BAR(0);
  DMA_K(3,0);DMA_V(1,SLOTB);
  ROT();
  kload8(kf,kp0+sl_cur);
  WAIT_BAR(2);
  s16x4 vlo[8],vhi[8]; u32x4 pw0,pw1,pw2,pw3;
  #define PKW(P,B) cvtpk_s(P[B],P[B+1])
  #define PAF(k) __builtin_bit_cast(bf16x8,pw##k)
  #define VFR(i) (bf16x8){vlo[i][0],vlo[i][1],vlo[i][2],vlo[i][3],vhi[i][0],vhi[i][1],vhi[i][2],vhi[i][3]}
  #define PIN(x) asm volatile("":"+v"(x))
  #define MX3(a,b,c) __builtin_fmaxf(__builtin_fmaxf((a),(b)),(c))
  #define GAPA(MF,A0,A1,A2,A3,W0,W1,PW) do{ MF; sacc+=A0; sacc+=A1; sacc+=A2; sacc+=A3; PIN(sacc); W0; W1; PIN(PW); SBAR(); }while(0)
  #define EX(v) __builtin_amdgcn_exp2f(v)
  #define GAPB(MF,X,B) do{ MF; X[B]=EX(X[B]); X[B+1]=EX(X[B+1]); X[B+2]=EX(X[B+2]); X[B+3]=EX(X[B+3]); PIN(X); SBAR(); }while(0)
  #define VRD(i) do{ vlo[i]=vtr(vp_+(((i)>>2)*4096+((i)&3)*1024)); vhi[i]=vtr(vp_+(((i)>>2)*4096+((i)&3)*1024+512)); }while(0)
  #define KRD(G,j) do{ if(G){ kload2(kf,kp0+sl_next,j); SBAR(); } }while(0)
  #define STEP(C0,C1,P0,P1,t,GK,GV,GL) do{ SBAR(); \
    const lds_cptr vp_=vp0+sl_prev; \
    VRD(0); SBAR(); float sacc=(P0[0]+P0[1]); \
    GAPA(C0=__builtin_amdgcn_mfma_f32_32x32x16_bf16(kf[0],qr[0],C0,0,0,0), P0[2],P0[3],P0[4],P0[5],     pw0[0]=PKW(P0,0), pw0[1]=PKW(P0,2), pw0); \
    VRD(4); SBAR(); GAPA(C1=__builtin_amdgcn_mfma_f32_32x32x16_bf16(kf[1],qr[0],C1,0,0,0), P0[6],P0[7],P0[8],P0[9],     pw0[2]=PKW(P0,4), pw0[3]=PKW(P0,6), pw0); \
    VRD(1); SBAR(); GAPA(C0=__builtin_amdgcn_mfma_f32_32x32x16_bf16(kf[2],qr[1],C0,0,0,0),   P0[10],P0[11],P0[12],P0[13], pw1[0]=PKW(P0,8), pw1[1]=PKW(P0,10), pw1); \
    VRD(5); SBAR(); GAPA(C1=__builtin_amdgcn_mfma_f32_32x32x16_bf16(kf[3],qr[1],C1,0,0,0),   P0[14],P0[15],P1[0],P1[1],   pw1[2]=PKW(P0,12),pw1[3]=PKW(P0,14), pw1); \
    VRD(2); SBAR(); GAPA(C0=__builtin_amdgcn_mfma_f32_32x32x16_bf16(kf[4],qr[2],C0,0,0,0),   P1[2],P1[3],P1[4],P1[5],     pw2[0]=PKW(P1,0), pw2[1]=PKW(P1,2), pw2); \
    VRD(6); SBAR(); GAPA(C1=__builtin_amdgcn_mfma_f32_32x32x16_bf16(kf[5],qr[2],C1,0,0,0),   P1[6],P1[7],P1[8],P1[9],     pw2[2]=PKW(P1,4), pw2[3]=PKW(P1,6), pw2); \
    VRD(3); SBAR(); GAPA(C0=__builtin_amdgcn_mfma_f32_32x32x16_bf16(kf[6],qr[3],C0,0,0,0),   P1[10],P1[11],P1[12],P1[13], pw3[0]=PKW(P1,8), pw3[1]=PKW(P1,10), pw3); \
    VRD(7); SBAR(); GAPA(C1=__builtin_amdgcn_mfma_f32_32x32x16_bf16(kf[7],qr[3],C1,0,0,0),   P1[14],P1[15],0.f,0.f,       pw3[2]=PKW(P1,12),pw3[3]=PKW(P1,14), pw3); \
    l_reg+=sacc; \
    if(GK){DMA_K((t)+3,sl_cur);} if(GV){DMA_V((t)+1,sl_next);} \
    CMASK(C0,C1,t); \
    REFTRACK(C0,C1); \
    SBAR(); \
    BLOAD(P0,P1,(t)+1); \
    GAPB(o[0]=__builtin_amdgcn_mfma_f32_32x32x16_bf16(PAF(0),VFR(0),o[0],0,0,0), C0,0); \
    GAPB(o[1]=__builtin_amdgcn_mfma_f32_32x32x16_bf16(PAF(0),VFR(4),o[1],0,0,0), C0,4); \
    KRD(GL,0); GAPB(o[0]=__builtin_amdgcn_mfma_f32_32x32x16_bf16(PAF(1),VFR(1),o[0],0,0,0), C0,8); \
    KRD(GL,1); GAPB(o[1]=__builtin_amdgcn_mfma_f32_32x32x16_bf16(PAF(1),VFR(5),o[1],0,0,0), C0,12); \
    KRD(GL,2); GAPB(o[0]=__builtin_amdgcn_mfma_f32_32x32x16_bf16(PAF(2),VFR(2),o[0],0,0,0), C1,0); \
    KRD(GL,3); GAPB(o[1]=__builtin_amdgcn_mfma_f32_32x32x16_bf16(PAF(2),VFR(6),o[1],0,0,0), C1,4); \
    GAPB(o[0]=__builtin_amdgcn_mfma_f32_32x32x16_bf16(PAF(3),VFR(3),o[0],0,0,0), C1,8); \
    GAPB(o[1]=__builtin_amdgcn_mfma_f32_32x32x16_bf16(PAF(3),VFR(7),o[1],0,0,0), C1,12); \
    BSUB(P0,P1); \
    }while(0)
  BLOAD(pB0,pB1,1); BSUB(pB0,pB1);
  int t=1;
  #undef CMASK
  #define CMASK(P0,P1,t) do{}while(0)
  for(;t+5<NT;t+=2){
    STEP(pB0,pB1,pA0,pA1,t,true,true,true);     WAIT_BAR(2); RESC(); ROT();
    STEP(pA0,pA1,pB0,pB1,t+1,true,true,true);   WAIT_BAR(2); RESC(); ROT();
  }
  #undef CMASK
  #define CMASK(P0,P1,t) do{int jb_=(t)-(NT-4); if(jb_>=0)cmask(P0,P1,jb_,qrel,hi);}while(0)
  #define ENDW(tt) do{ if((tt)+3<NT){WAIT_BAR(2);} else if((tt)+2<NT){WAIT_BAR(1);} else {WAIT_BAR(0);} }while(0)
  for(;t+1<NT;t+=2){
    STEP(pB0,pB1,pA0,pA1,t,(t+3<NT),(t+1<NT),(t+1<NT));       ENDW(t);   RESC(); ROT();
    STEP(pA0,pA1,pB0,pB1,t+1,(t+4<NT),(t+2<NT),(t+2<NT));     ENDW(t+1); RESC(); ROT();
  }
  STEP(pB0,pB1,pA0,pA1,NT-1,false,false,false); RESC();
  { float sacc=pB0[0]+pB0[1]; _Pragma("unroll") for(int r=2;r<16;++r)sacc+=pB0[r]; _Pragma("unroll") for(int r=0;r<16;++r)sacc+=pB1[r]; l_reg+=sacc;
    pw0=(u32x4){PKW(pB0,0),PKW(pB0,2),PKW(pB0,4),PKW(pB0,6)};pw1=(u32x4){PKW(pB0,8),PKW(pB0,10),PKW(pB0,12),PKW(pB0,14)};pw2=(u32x4){PKW(pB1,0),PKW(pB1,2),PKW(pB1,4),PKW(pB1,6)};pw3=(u32x4){PKW(pB1,8),PKW(pB1,10),PKW(pB1,12),PKW(pB1,14)};
    SBAR(); pv(o,vb0+sl_cur,PAF(0),PAF(1),PAF(2),PAF(3)); }
  #undef PKW
  #undef PAF
  #undef VFR
  #undef PIN
  #undef MX3
  #undef GAPA
  #undef GAPB
  #undef EX
  #undef VRD
  #undef KRD
  #undef STEP
  #undef ENDW
  {auto rr=__builtin_amdgcn_permlane32_swap(__float_as_uint(l_reg),__float_as_uint(l_reg),false,false);l_reg=__uint_as_float(rr[0])+__uint_as_float(rr[1]);}
  if(hi==0)wsf[32+r32]=l_reg;asm volatile("s_waitcnt lgkmcnt(0)":::"memory");
  float rli[16];
  #pragma unroll
  for(int r=0;r<16;++r)rli[r]=__builtin_amdgcn_rcpf(wsf[32+crow(r,hi)]);
  { bf16*stg=(bf16*)(shm+LDS_OST)+wid*2048;
    #pragma unroll
    for(int r=0;r<16;++r){const int orow=crow(r,hi);
      #pragma unroll
      for(int d0=0;d0<2;++d0)stg[orow*64+d0*32+r32]=__float2bfloat16(o[d0][r]*rli[r]);}
    asm volatile("s_waitcnt lgkmcnt(0)":::"memory");
    #pragma unroll
    for(int i=0;i<4;++i){const int row=i*8+(lane>>3),ch=lane&7; const u32x4 v=*(const u32x4*)(stg+row*64+ch*8);
      int o0=0,o1=0; o0=__builtin_amdgcn_cvt_pk_fp8_f32(bflo(v.x)*OUT_Y_SCALE,bfhi(v.x)*OUT_Y_SCALE,o0,false); o0=__builtin_amdgcn_cvt_pk_fp8_f32(bflo(v.y)*OUT_Y_SCALE,bfhi(v.y)*OUT_Y_SCALE,o0,true);
      o1=__builtin_amdgcn_cvt_pk_fp8_f32(bflo(v.z)*OUT_Y_SCALE,bfhi(v.z)*OUT_Y_SCALE,o1,false); o1=__builtin_amdgcn_cvt_pk_fp8_f32(bflo(v.w)*OUT_Y_SCALE,bfhi(v.w)*OUT_Y_SCALE,o1,true);
      *(v2u*)((unsigned char*)O+((rowbase+q0+wid*QBLK+row)*512+h*D+ch*8))=(v2u){(unsigned)o0,(unsigned)o1};} }
  asm volatile("s_waitcnt lgkmcnt(0)\n\ts_barrier":::"memory");
  #undef DMA_K
  #undef DMA_V
  #undef REFTRACK
  #undef CMASK
  #undef BIAS
  #undef BLOAD
  #undef BSUB
  #undef START
  #undef RESC
  #undef ROT
}
constexpr int ATTN_LDS_BYTES=LDS_BYTES;
struct AttnTensors { const bf16* Q; const bf16* K; const bf16* V; bf16* O; const float* FC; const int* TS; unsigned* queue; };
struct AttnUnit { int bh; int qb; };
struct StaticOrder {
  int vcu,G;
  __device__ __forceinline__ StaticOrder(int grid,int v):vcu(v),G(grid){}
  __device__ __forceinline__ bool next(int i,AttnUnit&u)const{ const int L=i*G+vcu; if(L>=BATCH*NHEAD*NQB)return false; const int s=L&3,jj=L>>8; u.bh=(L&255)>>2; u.qb=(jj==0)?s:(jj==1)?7-s:(jj==2)?8+s:15-s; return true; }
  __device__ __forceinline__ void a_ready(const AttnUnit&)const{}
  __device__ __forceinline__ void done(const AttnUnit&)const{}
};
constexpr int LDS_TS=102400, LDS_QW=LDS_TS+4096;
template<class Sched,class Extra,int THRL=8> __device__ __forceinline__ void attn_phase(int tid_in,char*lds,const AttnTensors&T,const Sched&S,const Extra&X){
  __attribute__((address_space(3))) int* tsl=(__attribute__((address_space(3))) int*)((__attribute__((address_space(3))) char*)lds+LDS_TS);
  __syncthreads();
  for(int i=tid_in;i<1024;i+=512)tsl[i]=T.TS[i];
  for(;;){
    __syncthreads();
    if(tid_in==0)tsl[1024]=(int)__hip_atomic_fetch_add(T.queue,1u,__ATOMIC_RELAXED,__HIP_MEMORY_SCOPE_AGENT);
    __syncthreads();
    const int Lq=__builtin_amdgcn_readfirstlane(tsl[1024]); if(Lq>=X.total(BATCH*NHEAD*NQB))break;
    int L; if(X.map(Lq,L)){X.run(L);continue;}
    const int qb=NQB-1-(L>>6),bh=L&63;
    attn_unit<THRL>(tid_in,bh/NHEAD,bh%NHEAD,qb,__builtin_amdgcn_readfirstlane(tsl[bh*16+qb]),T.Q,T.K,T.V,T.O,T.FC+(long)bh*SEQ,lds);
  }
}
#undef SBAR
#undef WAIT_BAR
}

extern __shared__ __attribute__((aligned(16))) unsigned char lds_dyn[];
template <class Extra> __device__ __forceinline__ void attn_phase_call(int tid_in, const bf16* Up, bf16* Yp, const float* FCp, const int* TSp, unsigned* queue, int G, int vcu, const Extra& X) {
    const attn_body::AttnTensors AT{(const attn_body::bf16*)(Up + UC_Q), (const attn_body::bf16*)(Up + UC_K), (const attn_body::bf16*)(Up + UC_V), (attn_body::bf16*)Yp, FCp, TSp, queue};
    const attn_body::StaticOrder S(G, vcu);
    attn_body::attn_phase<attn_body::StaticOrder, Extra>(tid_in, (char*)lds_dyn + RING_OFF, AT, S, X);
}
__device__ __forceinline__ void router_phase(Frame& F, const float* R, const float* gain, const float* wg, const float* bg, const float* we, const float* be, bf16* XN, unsigned* cursor, int* perm, float* roww) {
    LAS float* Wr = (LAS float*)(F.lds);
    LAS int* rq = (LAS int*)(F.lds + 81920);
    LAS float* rw = (LAS float*)(F.lds + 81920 + 512);
    LAS int* lbase = (LAS int*)(F.lds + 81920 + 512 + 1024);
    __syncthreads();
    for (int e = F.tid; e < 20 * 1024; e += 512) { const int o = e >> 10, k = e & 1023; Wr[e] = o < 4 ? wg[k * 4 + o] : we[k * 16 + (o - 4)]; }
    f32x4 g[4];
#pragma unroll
    for (int j = 0; j < 4; ++j) g[j] = *((const f32x4*)gain + F.lane + 64 * j);
    float bias[20];
#pragma unroll
    for (int o = 0; o < 20; ++o) bias[o] = o < 4 ? bg[o] : be[o - 4];
    __syncthreads();
    for (int rb = F.vcu; rb < M / 128; rb += F.G) {
        for (int i = 0; i < 16; ++i) {
            const int rl = F.wave * 16 + i, m = rb * 128 + rl;
            const f32x4* xr = (const f32x4*)(R + (size_t)m * DM) + F.lane; f32x4 v[4]; float s = 0.f;
#pragma unroll
            for (int j = 0; j < 4; ++j) { v[j] = xr[64 * j]; s += (v[j].x * v[j].x + v[j].y * v[j].y) + (v[j].z * v[j].z + v[j].w * v[j].w); }
            const float rstd = __builtin_amdgcn_rsqf(wave_sum(s) * (1.f / DM) + EPS);
            unsigned long long* o8 = (unsigned long long*)(XN + (size_t)m * DM) + F.lane;
#pragma unroll
            for (int j = 0; j < 4; ++j) { v[j] = v[j] * rstd * g[j]; o8[64 * j] = (unsigned long long)pk2(v[j].x, v[j].y) | ((unsigned long long)pk2(v[j].z, v[j].w) << 32); }
            float lg[20];
#pragma unroll
            for (int o = 0; o < 20; ++o) { float a = 0.f;
#pragma unroll
                for (int j = 0; j < 4; ++j) { const f32x4 w = *(const LAS f32x4*)(Wr + o * 1024 + 4 * F.lane + 256 * j); a += (v[j].x * w.x + v[j].y * w.y) + (v[j].z * w.z + v[j].w * w.w); }
                lg[o] = wave_sum(a) + bias[o]; }
            int gi = 0; float gm = lg[0];
#pragma unroll
            for (int o = 1; o < 4; ++o) if (lg[o] > gm) { gm = lg[o]; gi = o; }
            const float gsum = __expf(lg[0] - gm) + __expf(lg[1] - gm) + __expf(lg[2] - gm) + __expf(lg[3] - gm);
            const float gval = 1.0f / gsum;
            float es[4];
#pragma unroll
            for (int j = 0; j < 4; ++j) es[j] = gi == 0 ? lg[4 + j] : gi == 1 ? lg[8 + j] : gi == 2 ? lg[12 + j] : lg[16 + j];
            int e1 = 0; float v1 = es[0];
#pragma unroll
            for (int j = 1; j < 4; ++j) if (es[j] > v1) { v1 = es[j]; e1 = j; }
            int e2 = -1; float v2 = -3.0e38f;
#pragma unroll
            for (int j = 0; j < 4; ++j) if (j != e1 && es[j] > v2) { v2 = es[j]; e2 = j; }
            const float ex = __expf(v2 - v1), w1 = gval / (1.f + ex), w2 = gval * ex / (1.f + ex);
            const int lo = e1 < e2 ? e1 : e2, hi = e1 < e2 ? e2 : e1;
            const int pidx = lo == 0 ? hi - 1 : (lo == 1 ? hi + 1 : 5);
            if (F.lane == 0) { rq[rl] = gi * 6 + pidx; rw[rl * 2] = e1 < e2 ? w1 : w2; rw[rl * 2 + 1] = e1 < e2 ? w2 : w1; }
        }
        __syncthreads();
        if (F.tid < NBUCKET) { int c = 0; for (int r = 0; r < 128; ++r) c += (rq[r] == F.tid) ? 1 : 0;
            lbase[F.tid] = c ? (int)__hip_atomic_fetch_add(cursor + 64 * F.tid, (unsigned)c, RLX_AGENT) : 0; }
        __syncthreads();
        if (F.tid < 128) { const int q = rq[F.tid]; int rank = 0; for (int r = 0; r < F.tid; ++r) rank += (rq[r] == q) ? 1 : 0;
            const int pos = lbase[q] + rank; perm[q * BCAP + pos] = rb * 128 + F.tid; roww[((size_t)q * BCAP + pos) * 2] = rw[F.tid * 2]; roww[((size_t)q * BCAP + pos) * 2 + 1] = rw[F.tid * 2 + 1]; }
        __syncthreads();
    }
}

__device__ __forceinline__ void router_phase2(Frame& F, const float* R, const float* gain, const float* wg, const float* bg, const float* we, const float* be, bf16* XN, unsigned* cursor, int* perm, float* roww, float* rstdo) {
    LAS bf16* Wh = (LAS bf16*)(F.lds); LAS bf16* Wl = Wh + 20 * 1024;
    LAS float* gs = (LAS float*)(F.lds + 81920);
    LAS float* lgs = (LAS float*)(F.lds + TBL_OFF);
    LAS int* rq = (LAS int*)(F.lds + TBL_OFF + 10240);
    LAS float* rw = (LAS float*)(F.lds + TBL_OFF + 10240 + 512);
    LAS int* lbase = (LAS int*)(F.lds + TBL_OFF + 10240 + 512 + 1024);
    LAS float* rs = (LAS float*)(F.lds + TBL_OFF + 12288);
    __syncthreads();
#pragma unroll
    for (int kk = 0; kk < 2; ++kk) { const int k = F.tid + 512 * kk;
        const f32x4 g4 = *(const f32x4*)(wg + k * 4), e0 = *(const f32x4*)(we + k * 16), e1 = *(const f32x4*)(we + k * 16 + 4), e2 = *(const f32x4*)(we + k * 16 + 8), e3 = *(const f32x4*)(we + k * 16 + 12); const float gk = gain[k];
        const float wv[20] = {g4.x, g4.y, g4.z, g4.w, e0.x, e0.y, e0.z, e0.w, e1.x, e1.y, e1.z, e1.w, e2.x, e2.y, e2.z, e2.w, e3.x, e3.y, e3.z, e3.w};
#pragma unroll
        for (int o = 0; o < 20; ++o) { const float w = wv[o] * gk; const unsigned hb = f2bf(w), lb = f2bf(w - bf2f(hb)); const int idx = o * 1024 + ((((k >> 3) ^ (o & 15)) << 3) | (k & 7)); Wh[idx] = (bf16)hb; Wl[idx] = (bf16)lb; } }
    for (int k = F.tid; k < 1024; k += 512) gs[k] = gain[k] * MOE_X_SCALE;
    const int fr = F.lane & 15, fq = F.lane >> 4;
    float bias0[4], bias1[4];
#pragma unroll
    for (int j = 0; j < 4; ++j) { const int o0 = 4 * fq + j, o1 = 16 + 4 * fq + j; bias0[j] = o0 < 4 ? bg[o0] : be[o0 - 4]; bias1[j] = o1 < 20 ? be[o1 - 4] : 0.f; }
    __syncthreads();
    for (int rb = F.vcu; rb < M / 128; rb += F.G) {
        const int rl = F.wave * 16 + fr; const size_t row = (size_t)rb * 128 + rl;
        const float* xr = R + row * DM + fq * 8;
        f32x4 acc0 = {0.f, 0.f, 0.f, 0.f}, acc1 = acc0; float ssq = 0.f;
        const int or0 = fr, or1 = (16 + fr) < 20 ? 16 + fr : 19;
#pragma unroll 4
        for (int ks = 0; ks < 32; ++ks) {
            const f32x4 xa = *(const f32x4*)(xr + ks * 32), xb = *(const f32x4*)(xr + ks * 32 + 4);
            ssq += (xa.x * xa.x + xa.y * xa.y) + (xa.z * xa.z + xa.w * xa.w) + (xb.x * xb.x + xb.y * xb.y) + (xb.z * xb.z + xb.w * xb.w);
            const v4u ahw = (v4u){pk2(xa.x, xa.y), pk2(xa.z, xa.w), pk2(xb.x, xb.y), pk2(xb.z, xb.w)};
            const v4u alw = (v4u){pk2(xa.x - bflo(ahw.x), xa.y - bfhi(ahw.x)), pk2(xa.z - bflo(ahw.y), xa.w - bfhi(ahw.y)), pk2(xb.x - bflo(ahw.z), xb.y - bfhi(ahw.z)), pk2(xb.z - bflo(ahw.w), xb.w - bfhi(ahw.w))};
            const bf16x8 ah = __builtin_bit_cast(bf16x8, ahw), al = __builtin_bit_cast(bf16x8, alw);
            const int c0 = ((ks * 4 + fq) ^ (or0 & 15)) << 3, c1 = ((ks * 4 + fq) ^ (or1 & 15)) << 3;
            const bf16x8 wh0 = *(const LAS bf16x8*)(Wh + or0 * 1024 + c0), wl0 = *(const LAS bf16x8*)(Wl + or0 * 1024 + c0);
            const bf16x8 wh1 = *(const LAS bf16x8*)(Wh + or1 * 1024 + c1), wl1 = *(const LAS bf16x8*)(Wl + or1 * 1024 + c1);
            acc0 = __builtin_amdgcn_mfma_f32_16x16x32_bf16(wh0, ah, acc0, 0, 0, 0); acc0 = __builtin_amdgcn_mfma_f32_16x16x32_bf16(wh0, al, acc0, 0, 0, 0); acc0 = __builtin_amdgcn_mfma_f32_16x16x32_bf16(wl0, ah, acc0, 0, 0, 0);
            acc1 = __builtin_amdgcn_mfma_f32_16x16x32_bf16(wh1, ah, acc1, 0, 0, 0); acc1 = __builtin_amdgcn_mfma_f32_16x16x32_bf16(wh1, al, acc1, 0, 0, 0); acc1 = __builtin_amdgcn_mfma_f32_16x16x32_bf16(wl1, ah, acc1, 0, 0, 0);
            { const f32x4 ga = *(const LAS f32x4*)(gs + ks * 32 + fq * 8), gb = *(const LAS f32x4*)(gs + ks * 32 + fq * 8 + 4);
              int o0 = 0, o1 = 0; o0 = __builtin_amdgcn_cvt_pk_fp8_f32(xa.x * ga.x, xa.y * ga.y, o0, false); o0 = __builtin_amdgcn_cvt_pk_fp8_f32(xa.z * ga.z, xa.w * ga.w, o0, true);
              o1 = __builtin_amdgcn_cvt_pk_fp8_f32(xb.x * gb.x, xb.y * gb.y, o1, false); o1 = __builtin_amdgcn_cvt_pk_fp8_f32(xb.z * gb.z, xb.w * gb.w, o1, true);
              *(v2u*)((unsigned char*)XN + row * DM + fq * 8 + ks * 32) = (v2u){(unsigned)o0, (unsigned)o1}; }
        }
        ssq += __builtin_bit_cast(float, __builtin_amdgcn_ds_bpermute((F.lane ^ 16) << 2, __builtin_bit_cast(int, ssq)));
        ssq += __builtin_bit_cast(float, __builtin_amdgcn_ds_bpermute((F.lane ^ 32) << 2, __builtin_bit_cast(int, ssq)));
        const float rstd = __builtin_amdgcn_rsqf(ssq * (1.f / DM) + EPS);
#pragma unroll
        for (int j = 0; j < 4; ++j) { lgs[rl * 20 + 4 * fq + j] = acc0[j] * rstd + bias0[j]; if (fq == 0) lgs[rl * 20 + 16 + j] = acc1[j] * rstd + bias1[j]; }
        if (fq == 0) rs[rl] = rstd;
        LDS_WAIT(); asm volatile("" ::: "memory");
        if (F.lane < 16) {
            const int tl = F.wave * 16 + F.lane; float lg[20];
#pragma unroll
            for (int o = 0; o < 20; ++o) lg[o] = lgs[tl * 20 + o];
            int gi = 0; float gm = lg[0];
#pragma unroll
            for (int o = 1; o < 4; ++o) if (lg[o] > gm) { gm = lg[o]; gi = o; }
            const float gsum = __expf(lg[0] - gm) + __expf(lg[1] - gm) + __expf(lg[2] - gm) + __expf(lg[3] - gm);
            const float gval = 1.0f / gsum;
            float es[4];
#pragma unroll
            for (int j = 0; j < 4; ++j) es[j] = gi == 0 ? lg[4 + j] : gi == 1 ? lg[8 + j] : gi == 2 ? lg[12 + j] : lg[16 + j];
            int e1 = 0; float v1 = es[0];
#pragma unroll
            for (int j = 1; j < 4; ++j) if (es[j] > v1) { v1 = es[j]; e1 = j; }
            int e2 = -1; float v2 = -3.0e38f;
#pragma unroll
            for (int j = 0; j < 4; ++j) if (j != e1 && es[j] > v2) { v2 = es[j]; e2 = j; }
            const float ex = __expf(v2 - v1), w1 = gval / (1.f + ex), w2 = gval * ex / (1.f + ex);
            const int lo = e1 < e2 ? e1 : e2, hi = e1 < e2 ? e2 : e1;
            const int pidx = lo == 0 ? hi - 1 : (lo == 1 ? hi + 1 : 5);
            rq[tl] = gi * 6 + pidx; rw[tl * 2] = e1 < e2 ? w1 : w2; rw[tl * 2 + 1] = e1 < e2 ? w2 : w1;
        }
        __syncthreads();
        int myq = 0, myrank = 0;
        if (F.tid < 128) { myq = rq[F.tid];
            const unsigned long long lt = (1ull << F.lane) - 1ull;
#pragma unroll 4
            for (int q = 0; q < NBUCKET; ++q) { const unsigned long long mk = __ballot(myq == q); if (myq == q) myrank = __builtin_popcountll(mk & lt); if (F.lane == 0) lbase[32 + F.wave * 32 + q] = __builtin_popcountll(mk); } }
        __syncthreads();
        if (F.tid < NBUCKET) { const int c0 = lbase[32 + F.tid], c1 = lbase[64 + F.tid], c = c0 + c1;
            lbase[F.tid] = c ? (int)__hip_atomic_fetch_add(cursor + 64 * F.tid, (unsigned)c, RLX_AGENT) : 0; }
        __syncthreads();
        if (F.tid < 128) { const int pos = lbase[myq] + myrank + (F.wave ? lbase[32 + myq] : 0); perm[myq * BCAP + pos] = rb * 128 + F.tid; roww[((size_t)myq * BCAP + pos) * 2] = rw[F.tid * 2]; roww[((size_t)myq * BCAP + pos) * 2 + 1] = rw[F.tid * 2 + 1]; rstdo[(size_t)myq * BCAP + pos] = rs[F.tid]; }
        __syncthreads();
    }
}

__device__ __forceinline__ void moe_tables(Frame& F, unsigned* cursor, const int* perm, int ntn, bool fused = false) {
    LAS int* tbl = (LAS int*)(F.lds + TBL_OFF);
    __syncthreads();
    if (F.tid < NBUCKET) { int c = (int)__hip_atomic_load(cursor + 64 * F.tid, RLX_AGENT); c = c < 0 ? 0 : (c > BCAP ? BCAP : c); tbl[F.tid] = c; }
    __syncthreads();
    if (F.tid == 0) { int T = 0;
        for (int q = 0; q < NBUCKET; ++q) { const int nt = (tbl[q] + 255) >> 8;
            for (int tb = 0; tb < nt && T < 192; ++tb) { tbl[32 + T] = q; tbl[32 + 192 + T] = tb; ++T; } }
        tbl[32 + 192 + 192] = T; }
    __syncthreads();
    {
        const int ttot = tbl[32 + 192 + 192];
        int tokv[TOK_UNITS];
#pragma unroll
        for (int i = 0; i < TOK_UNITS; ++i) { const int L = i * F.G + F.vcu; tokv[i] = 0;
            int mt = -1; if (fused) { if (L < ttot * 8) mt = L >> 3; else if (L < ttot * 12) mt = (L - ttot * 8) >> 2; } else if (L < ttot * ntn) mt = L / ntn;
            if (mt >= 0 && F.tid < 256) { const int q = tbl[32 + mt], tb = tbl[32 + 192 + mt], cnt = tbl[q]; int r = tb * 256 + F.tid; r = r < cnt ? r : cnt - 1; tokv[i] = perm[q * BCAP + r]; } }
#pragma unroll
        for (int i = 0; i < TOK_UNITS; ++i) { const int L = i * F.G + F.vcu; if (L < ttot * (fused ? 12 : ntn) && F.tid < 256) tbl[(TOK_OFF - TBL_OFF) / 4 + i * 256 + F.tid] = tokv[i]; }
        __syncthreads();
    }
}

constexpr int PH_PER_LAYER = 9, N_PHASES = 1 + DEPTH * PH_PER_LAYER;
__global__ void __launch_bounds__(512, 2) hybrid_fwd(Args args) {
    Frame F;
    F.lds = (LAS unsigned char*)lds_dyn;
    F.MISC = (volatile LAS unsigned*)(F.lds + MISC_OFF);
    F.tid = threadIdx.x; F.lane = F.tid & 63; F.wave = __builtin_amdgcn_readfirstlane(F.tid >> 6); F.wave0 = F.wave;
    F.G = gridDim.x; { const int bx = blockIdx.x; F.vcu = (F.G % 8 == 0) ? (bx % 8) * (F.G / 8) + bx / 8 : bx; F.vcu0 = F.vcu; F.G0 = F.G; }
    for (int u = F.tid; u < (LDS_BYTES - LDSCTL_OFF) / 4; u += 512) ((LAS unsigned*)(F.lds + LDSCTL_OFF))[u] = 0u;
    __syncthreads();
    if (F.tid < 26) { const unsigned long long pv = F.tid < 24 ? (unsigned long long)args.in[F.tid] : (F.tid == 24 ? (unsigned long long)args.ws : (unsigned long long)args.out);
        ((LAS unsigned*)(F.lds + PTAB_OFF))[2 * F.tid] = (unsigned)pv; ((LAS unsigned*)(F.lds + PTAB_OFF))[2 * F.tid + 1] = (unsigned)(pv >> 32); }
    __syncthreads();
    unsigned char* ws = (unsigned char*)inptr(F, 24);
    F.ctl = (gu32*)(ws + WS_CTL);
    XcdBarrier bar; bar.bar = (unsigned*)(F.ctl + CW_BAR); bar.x = 0; bar.st = nullptr;
    if (!MK_PER_PHASE) bar = xcd_barrier_post((unsigned*)(F.ctl + CW_BAR), F.MISC + 8);
#define GRID_BAR(seam) do { if (MK_PER_PHASE) { if (F.tid == 0) __hip_atomic_store(F.ctl + CW_TMO, 0xBADBA0u | (unsigned)(seam), RLX_AGENT); } else { xcd_barrier(bar); if (DUPN(14) > 1) xcd_barrier(bar); } } while (0)
    const int lo = args.ph_lo, hi = args.ph_hi;
#ifndef PREMIX_MASK
#define PREMIX_MASK 7
#endif
#ifndef MOE_FUSED
#define MOE_FUSED 1
#endif
#ifndef PHMASK
#define PHMASK 0x3ff
#endif
#define INM(j) ((PHMASK >> (j)) & 1)
#define IN(k) (lo <= (k) && (k) < hi && relaunder(F))
#define BOTH(k) (lo <= (k) && (k) + 1 < hi)
#define WSP ((unsigned char*)inptr(F, 24))
#define XN ((bf16*)(WSP + WS_XN))
#define Y ((bf16*)(WSP + WS_XN))
#define U ((bf16*)(WSP + WS_U))
#define H ((bf16*)(WSP + WS_U))
#define FD ((float*)(WSP + WS_FD))
#define FC ((float*)(WSP + WS_FC))
#define PERM ((int*)(WSP + WS_PERM))
#define ROWW ((float*)(WSP + WS_ROWW))
#define R ((float*)inptr(F, 25))

    if (IN(0) && INM(9)) { for (int rep = 0; rep < DUPN(9); ++rep) prologue_phase(F, WSP); if (BOTH(0)) GRID_BAR(0); }

#if USE_NAIVE_ATTN
#define ATTN_PHASE_CALL(l) attn_naive_phase(F, U, FC, Y)
#else
#define ATTN_PHASE_CALL(l) do { if ((l) == 0) { const MoeConvExtra X_{&F, WSP}; attn_phase_call(F.tid, U, (bf16*)(WSP + WS_XN8), FC, (const int*)(WSP + WS_CD + 65536), (unsigned*)(F.ctl + CW_ATQ + lp * 64), F.G, F.vcu, X_); } \
        else { const NoExtra X_{}; attn_phase_call(F.tid, U, (bf16*)(WSP + WS_XN8), FC, (const int*)(WSP + WS_CD + 65536), (unsigned*)(F.ctl + CW_ATQ + lp * 64), F.G, F.vcu, X_); } } while (0)
#endif
#if USE_NAIVE_SSD
#define NSSDU 16
#define SSD_A_UNITS() do { for (int it = F.vcu; it < NSSDU; it += F.G) { __syncthreads(); ssd_seq_unit(F, it, U, FD, Y, inptr(F, 8) + (size_t)lp * 4 * 768, inptr(F, 9) + (size_t)lp * 768, inptr(F, 10) + lp * 8, inptr(F, 11) + lp * 8, inptr(F, 12) + lp * 8); __syncthreads(); } } while (0)
#define SSD_SCAN() do { } while (0)
#define SSD_SCAN_WAIT() do { } while (0)
#define SSD_B_PHASE() ssd_norm_phase(F, Y, inptr(F, 13) + lp * 512)
#else
#define NSSDU 256
#define SSD_A_UNITS() do { const bf16* u_ = U; const float* fd_ = FD; float* sst_ = (float*)(WSP + WS_SST); float* cd_ = (float*)(WSP + WS_CD); \
        const float* p8_ = inptr(F, 8) + (size_t)lp * 4 * 768; const float* p9_ = inptr(F, 9) + (size_t)lp * 768; const float* p10_ = inptr(F, 10) + lp * 8; const float* p11_ = inptr(F, 11) + lp * 8; \
        for (int it = F.vcu; it < NSSDU; it += F.G) { for (int r2 = 0; r2 < DUPN(11); ++r2) ssd_passA_unit(F, it, u_, fd_, sst_, cd_, p8_, p9_, p10_, p11_); } } while (0)
#define SSD_SCAN() ssd_scan_phase(F, (const float*)(WSP + WS_SST), (const float*)(WSP + WS_CD), (bf16*)(WSP + WS_HPB), (unsigned*)(F.ctl + CW_SCN + lp * 64))
#define SSD_SCAN_WAIT() ssd_scan_wait(F, (unsigned*)(F.ctl + CW_SCN + lp * 64))
#define SSD_B_PHASE() do { const bf16* u_ = U; const float* fd_ = FD; const bf16* hpb_ = (const bf16*)(WSP + WS_HPB); bf16* y_ = Y; \
        const float* p8_ = inptr(F, 8) + (size_t)lp * 4 * 768; const float* p9_ = inptr(F, 9) + (size_t)lp * 768; const float* p10_ = inptr(F, 10) + lp * 8; const float* p11_ = inptr(F, 11) + lp * 8; const float* p12_ = inptr(F, 12) + lp * 8; const float* p13_ = inptr(F, 13) + lp * 512; \
        for (int it = F.vcu; it < 256; it += F.G) ssd_passB_unit(F, it, u_, fd_, hpb_, y_, p8_, p9_, p10_, p11_, p12_, p13_); } while (0)
#endif
#define LAYER_BODY(l) { \
        const int P = 1 + l * PH_PER_LAYER; \
        if (IN(P + 0) && INM(0)) { const int lp = opaque_s(l); \
            for (int rep = 0; rep < DUPN(0); ++rep) { \
                { DenseSched S{(const char*)(WSP + WS_WIN8) + (size_t)lp * NV_IN * DM, M / 256, NT8, DM, DM, F.G, opaque_s((int)blockIdx.x), 0}; \
                  EpiIn<true> E{U, FD}; \
                  if (DUPN(12) > 1) { GEMM_PHASE8(F, (const char*)(WSP + WS_XN8), DM / 128, DM, DM, S, E); relaunder(F); } GEMM_PHASE8(F, (const char*)(WSP + WS_XN8), DM / 128, DM, DM, S, E); } \
                relaunder(F); \
                { DenseSched S{(const char*)(WSP + WS_WIN) + ((size_t)lp * NV_IN + NT8 * 256) * DM * 2, M / 256, NV_IN / 256 - NT8, DM * 2, DM * 2, F.G, opaque_s((int)blockIdx.x), NT8}; \
                  EpiIn<false> E{U, FD}; \
                  if (DUPN(13) > 1) { GEMM_PHASE(F, (const char*)XN, DM * 2 / 128, DM * 2, DM * 2, S, E); relaunder(F); } GEMM_PHASE(F, (const char*)XN, DM * 2 / 128, DM * 2, DM * 2, S, E); } } \
            if (BOTH(P + 0)) GRID_BAR(P + 0); \
        } \
        if (IN(P + 1) && INM(1)) { const int lp = opaque_s(l); \
            for (int rep = 0; rep < DUPN(1); ++rep) { \
                SSD_A_UNITS(); \
                { const float* fd_ = FD; const float* p7_ = inptr(F, 7) + lp * 8; float* fc_ = FC; int* ts_ = (int*)(WSP + WS_CD + 65536); for (int it = F.vcu; it < 64; it += F.G) fcum_unit(F, it, fd_, p7_, fc_, ts_); } \
                for (int r2 = 0; r2 < DUPN(10); ++r2) { const int cfirst = (F.vcu + 64) % F.G; \
                    conv_units(F, cfirst, 1024, U, inptr(F, 3) + (size_t)lp * 31 * 512, inptr(F, 4) + lp * 512, inptr(F, 5) + lp * 512, inptr(F, 6) + lp * 512, Y); } \
            } \
            if (BOTH(P + 1)) GRID_BAR(P + 1); \
        } \
        if (IN(P + 2) && INM(2)) { const int lp = opaque_s(l); \
            SSD_SCAN(); \
            ATTN_PHASE_CALL(l); \
            SSD_SCAN_WAIT(); \
            SSD_B_PHASE(); \
            if (BOTH(P + 2)) GRID_BAR(P + 2); } \
        if (IN(P + 3) && INM(3)) { } \
        if (IN(P + 4) && INM(4)) { const int lp = opaque_s(l); \
            OutSched S{(const char*)(WSP + WS_WOUT) + (size_t)lp * DM * D_MIX * 2, (const char*)(WSP + WS_WOUT8) + (size_t)lp * DM * 512, (const char*)(WSP + WS_XN8), M / 256, DM / 256, D_MIX * 2, D_MIX * 2, F.G, opaque_s((int)blockIdx.x)}; \
            EpiOut E{lp == 0 ? inptr(F, 0) : (const float*)R, R}; \
            GEMM_PHASE(F, (const char*)Y, 20, D_MIX * 2, D_MIX * 2, S, E); \
            if (BOTH(P + 4)) GRID_BAR(P + 4); \
        } \
        if (IN(P + 5) && INM(5)) { const int lp = opaque_s(l); \
            router_phase2(F, R, inptr(F, 15) + lp * DM, inptr(F, 16) + (size_t)lp * DM * 4, inptr(F, 17) + lp * 4, inptr(F, 18) + (size_t)lp * DM * 16, inptr(F, 19) + lp * 16, XN, \
                         (unsigned*)(F.ctl + CW_CUR + lp * 2048), PERM, ROWW, (float*)(WSP + WS_RSTD)); \
            if (BOTH(P + 5)) GRID_BAR(P + 5); \
        } \
        if (MOE_FUSED) { \
        if (IN(P + 6) && INM(6)) { const int lp = opaque_s(l); \
            moe_tables(F, (unsigned*)(F.ctl + CW_CUR + lp * 2048), PERM, 12, true); \
            MoeSchedF S{(const LAS int*)(F.lds + TBL_OFF), PERM, (const char*)(WSP + WS_WGU) + (size_t)lp * NEXP * 1024 * 1024, (const char*)(WSP + WS_WD) + (size_t)lp * NEXP * 1024 * 512, \
                        (unsigned)WS_XN, (unsigned)WS_U, F.ctl + CW_HRDY + lp * 4096, F.ctl + CW_TMO, F.G, F.vcu}; \
            EpiF E{EpiGU_<true>{H, ROWW, (const float*)(WSP + WS_RSTD)}, EpiDown{R, PERM, (const LAS int*)(F.lds + TOK_OFF)}, F.ctl + CW_HRDY + lp * 4096}; \
            GEMM_PHASE8(F, (const char*)WSP, 8, 1024, 1024, S, E); \
            if (BOTH(P + 6)) GRID_BAR(P + 6); \
        } \
        } else { \
        if (IN(P + 6) && INM(6)) { const int lp = opaque_s(l); \
            moe_tables(F, (unsigned*)(F.ctl + CW_CUR + lp * 2048), PERM, 8); \
            MoeSched<false> S{(const LAS int*)(F.lds + TBL_OFF), PERM, (const char*)(WSP + WS_WGU) + (size_t)lp * NEXP * 1024 * 1024, 8, F.G, F.vcu}; \
            EpiGU E{H, ROWW, (const float*)(WSP + WS_RSTD)}; \
            for (int rep = 0; rep < DUPN(6); ++rep) GEMM_PHASE8(F, (const char*)XN, 8, 1024, 1024, S, E); \
            if (BOTH(P + 6)) GRID_BAR(P + 6); \
        } \
        if (IN(P + 7) && INM(7)) { const int lp = opaque_s(l); \
            moe_tables(F, (unsigned*)(F.ctl + CW_CUR + lp * 2048), PERM, 4); \
            MoeSched<true> S{(const LAS int*)(F.lds + TBL_OFF), PERM, (const char*)(WSP + WS_WD) + (size_t)lp * NEXP * 1024 * 512, 4, F.G, F.vcu}; \
            EpiDown E{R, PERM, (const LAS int*)(F.lds + TOK_OFF)}; \
            GEMM_PHASE8(F, (const char*)H, 8, 1024, 512, S, E); \
            if (BOTH(P + 7)) GRID_BAR(P + 7); \
        } \
        } \
        if (IN(P + 8) && INM(8)) { const int lp = opaque_s(l); \
            if (lp + 1 < DEPTH) { for (int rep = 0; rep < DUPN(8); ++rep) norm_rows_phase(F, R, inptr(F, 1) + (size_t)(lp + 1) * DM, XN, WSP + WS_XN8); if (BOTH(P + 8)) GRID_BAR(P + 8); } \
            else final_norm_phase(F, R, inptr(F, 23), R); \
        } \
    }
    LAYER_BODY(0)
    LAYER_BODY(1)
#undef LAYER_BODY
#undef ATTN_PHASE_CALL
#undef IN
#undef BOTH
#undef WSP
#undef XN
#undef Y
#undef U
#undef H
#undef FD
#undef FC
#undef PERM
#undef ROWW
#undef R
}

extern "C" void kernel_launch(void* const* d_in, const int* in_sizes, int n_in, void* d_out, int out_size, void* d_ws, size_t ws_size, hipStream_t stream) {
    static int grid = 0;
    if (grid == 0) {
        if (n_in != 24 || in_sizes[0] != M * DM || out_size != M * DM || ws_size < WS_END) { fprintf(stderr, "kernel_launch: unexpected shapes: n_in %d in0 %d out %d ws %zu (need %zu)\n", n_in, n_in > 0 ? in_sizes[0] : -1, out_size, ws_size, (size_t)WS_END); grid = -1; return; }
        int dev = 0, cus = 0, per_cu = 0;
        if (hipGetDevice(&dev) != hipSuccess || hipDeviceGetAttribute(&cus, hipDeviceAttributeMultiprocessorCount, dev) != hipSuccess) { grid = -1; return; }
        if (hipFuncSetAttribute((const void*)hybrid_fwd, hipFuncAttributeMaxDynamicSharedMemorySize, LDS_BYTES) != hipSuccess) { fprintf(stderr, "kernel_launch: hipFuncSetAttribute failed\n"); grid = -1; return; }
        if (hipOccupancyMaxActiveBlocksPerMultiprocessor(&per_cu, (const void*)hybrid_fwd, 512, LDS_BYTES) != hipSuccess || per_cu < 1) fprintf(stderr, "kernel_launch: occupancy query says %d\n", per_cu);
        (void)hipGetLastError();
        grid = cus;
    }
    if (grid < 0) return;
    if (hipMemsetAsync((char*)d_ws + WS_CTL, 0, CTL_ZERO_BYTES, stream) != hipSuccess) return;
    Args a{};
    for (int i = 0; i < 24; ++i) a.in[i] = (const float*)d_in[i];
    a.out = (float*)d_out; a.ws = (unsigned char*)d_ws; a.pad = 0;
#if MK_PER_PHASE
    for (int p = 0; p < N_PHASES; ++p) { a.ph_lo = p; a.ph_hi = p + 1; a.li = p; hipLaunchKernelGGL(hybrid_fwd, dim3(grid), dim3(512), LDS_BYTES, stream, a); }
#else
    a.ph_lo = 0; a.ph_hi = N_PHASES; a.li = 0;
    hipLaunchKernelGGL(hybrid_fwd, dim3(grid), dim3(512), LDS_BYTES, stream, a);
#endif
}
```
